# Optimizing an MI355X kernel written in HIP

```python
import jax, jax.numpy as jnp
from jax import lax
import numpy as np

D_MODEL = 1024
BATCH = 4
SEQ = 4096
DEPTH = 1

ROPE_THETA = 500000.0
BLOCK = 128
NEG = -1e30
RMS_EPS = 1e-6
LN_EPS = 1e-5

MLA_HEADS = 8
MLA_NOPE_DIM = 64
MLA_ROPE_DIM = 32
MLA_V_DIM = 64
Q_LORA_RANK = 384
KV_LORA_RANK = 256
MLA_WIDTH = MLA_HEADS * MLA_V_DIM

DIL_HEADS = 8
DIL_HEAD_DIM = 64
DIL_ROT_DIM = DIL_HEAD_DIM // 4
DIL_WIDTH = DIL_HEADS * DIL_HEAD_DIM
DIL_CONFIGS = ((128, 1), (512, 4), (2048, 16))

MIX_WIDTH = MLA_WIDTH + DIL_WIDTH
IN_SPLITS = (Q_LORA_RANK, KV_LORA_RANK, MLA_ROPE_DIM, MLA_WIDTH, DIL_WIDTH, DIL_WIDTH, DIL_WIDTH, DIL_WIDTH)
IN_WIDTH = sum(IN_SPLITS)

DEEPNORM_ALPHA = (2.0 * DEPTH) ** 0.25
DEEPNORM_BETA = (8.0 * DEPTH) ** -0.25

kernel_name = "hybrid_mla_dilated_deepnorm"


def rmsnorm(t, g):
    tf = t.astype(jnp.float32)
    tf = tf * lax.rsqrt(jnp.mean(tf * tf, axis=-1, keepdims=True) + RMS_EPS)
    return (tf * g.astype(jnp.float32)).astype(t.dtype)


def layernorm(t, g, b):
    tf = t.astype(jnp.float32)
    mu = jnp.mean(tf, axis=-1, keepdims=True)
    var = jnp.mean(jnp.square(tf - mu), axis=-1, keepdims=True)
    return ((tf - mu) * lax.rsqrt(var + LN_EPS) * g.astype(jnp.float32) + b.astype(jnp.float32)).astype(t.dtype)


def rope_tables(seq_len, dim):
    inv_freq = ROPE_THETA ** (-jnp.arange(0, dim, 2, dtype=jnp.float32) / dim)
    ang = jnp.arange(seq_len, dtype=jnp.float32)[:, None] * inv_freq[None, :]
    return jnp.cos(ang), jnp.sin(ang)


def apply_rope(t, cos, sin):
    t1, t2 = jnp.split(t.astype(jnp.float32), 2, axis=-1)
    c, s = cos[:, None, :], sin[:, None, :]
    return jnp.concatenate([t1 * c - t2 * s, t1 * s + t2 * c], axis=-1).astype(t.dtype)


def mla_attention(c_q, c_kv, k_rope, q_norm_g, kv_norm_g, w_uq, w_ukv):
    B, S, _ = c_q.shape
    H, DN, DR, DV = MLA_HEADS, MLA_NOPE_DIM, MLA_ROPE_DIM, MLA_V_DIM
    cos, sin = rope_tables(S, DR)
    q = (rmsnorm(c_q, q_norm_g) @ w_uq).reshape(B, S, H, DN + DR)
    q = jnp.concatenate([q[..., :DN], apply_rope(q[..., DN:], cos, sin)], axis=-1)
    kv = (rmsnorm(c_kv, kv_norm_g) @ w_ukv).reshape(B, S, H, DN + DV)
    k_nope, v = kv[..., :DN], kv[..., DN:]
    k_pe = apply_rope(k_rope[:, :, None, :], cos, sin)
    k = jnp.concatenate([k_nope, jnp.broadcast_to(k_pe, (B, S, H, DR))], axis=-1)
    scale = (DN + DR) ** -0.5
    nblk = S // BLOCK
    qb = q.reshape(B, nblk, BLOCK, H, DN + DR).transpose(1, 0, 3, 2, 4)
    kpos = jnp.arange(S)

    def one_block(args):
        q_blk, i = args
        s = jnp.einsum('bhqd,bkhd->bhqk', q_blk, k).astype(jnp.float32) * scale
        qpos = i * BLOCK + jnp.arange(BLOCK)
        s = jnp.where(kpos[None, :] <= qpos[:, None], s, NEG)
        p = jax.nn.softmax(s, axis=-1)
        return jnp.einsum('bhqk,bkhd->bqhd', p.astype(v.dtype), v)

    out = lax.map(one_block, (qb, jnp.arange(nblk)))
    return out.transpose(1, 0, 2, 3, 4).reshape(B, S, H * DV)


def dilated_branch(q, k, v, window, dilation):
    B, S, H, D = q.shape
    n_back = window // dilation
    seg = dilation * BLOCK
    S_pad = -(-S // seg) * seg
    pad = ((0, 0), (0, S_pad - S), (0, 0), (0, 0))
    L = S_pad // dilation
    nb = L // BLOCK

    def to_sub(t):
        t = jnp.pad(t, pad).reshape(B, L, dilation, H, D).transpose(0, 2, 3, 1, 4)
        return t.reshape(B, dilation, H, nb, BLOCK, D)

    def with_prev(t):
        prev = jnp.pad(t, ((0, 0), (0, 0), (0, 0), (1, 0), (0, 0), (0, 0)))[:, :, :, :-1]
        return jnp.concatenate([prev, t], axis=4)

    qs = to_sub(q)
    ks = with_prev(to_sub(k))
    vs = with_prev(to_sub(v))
    s = jnp.einsum('bdhnqe,bdhnke->bdhnqk', qs, ks).astype(jnp.float32)
    q_loc = jnp.arange(BLOCK)
    k_loc = jnp.arange(2 * BLOCK) - BLOCK
    dist = q_loc[:, None] - k_loc[None, :]
    valid = (jnp.arange(nb)[:, None, None] * BLOCK + k_loc[None, None, :]) >= 0
    mask = (dist >= 0) & (dist <= n_back) & valid
    s = jnp.where(mask, s, NEG)
    m = jnp.max(s, axis=-1, keepdims=True)
    p = jnp.exp(s - m)
    l = jnp.sum(p, axis=-1, keepdims=True)
    num = jnp.einsum('bdhnqk,bdhnke->bdhnqe', p, vs.astype(jnp.float32))

    def to_seq(t):
        c = t.shape[-1]
        t = t.reshape(B, dilation, H, L, c).transpose(0, 3, 1, 2, 4).reshape(B, S_pad, H, c)
        return t[:, :S]

    return to_seq(num), to_seq(m), to_seq(l)


def dilated_attention(q, k, v):
    B, S, _ = q.shape
    H, D = DIL_HEADS, DIL_HEAD_DIM
    cos, sin = rope_tables(S, DIL_ROT_DIM)

    def heads_rope(t):
        t = t.reshape(B, S, H, D)
        return jnp.concatenate([apply_rope(t[..., :DIL_ROT_DIM], cos, sin), t[..., DIL_ROT_DIM:]], axis=-1)

    qh = heads_rope(q) * (D ** -0.5)
    kh = heads_rope(k)
    vh = v.reshape(B, S, H, D)
    parts = [dilated_branch(qh, kh, vh, w, d) for (w, d) in DIL_CONFIGS]
    m_all = jnp.max(jnp.stack([pm for (_, pm, _) in parts], axis=0), axis=0)
    num = jnp.zeros((B, S, H, D), jnp.float32)
    den = jnp.zeros((B, S, H, 1), jnp.float32)
    for (pn, pm, pl) in parts:
        w = jnp.exp(pm - m_all)
        num = num + w * pn
        den = den + w * pl
    return (num / den).astype(q.dtype).reshape(B, S, H * D)


def setup_inputs(seed: int = 0) -> dict:
    key = jax.random.key(seed)
    ks = jax.random.split(key, 9)
    f32 = jnp.float32
    x = jax.random.normal(ks[0], (BATCH, SEQ, D_MODEL), f32)
    w_in = jax.random.normal(ks[1], (D_MODEL, IN_WIDTH), f32) * D_MODEL ** -0.5
    q_norm_g = 1.0 + 0.02 * jax.random.normal(ks[2], (Q_LORA_RANK,), f32)
    kv_norm_g = 1.0 + 0.02 * jax.random.normal(ks[3], (KV_LORA_RANK,), f32)
    w_uq = jax.random.normal(ks[4], (Q_LORA_RANK, MLA_HEADS * (MLA_NOPE_DIM + MLA_ROPE_DIM)), f32) * Q_LORA_RANK ** -0.5
    w_ukv = jax.random.normal(ks[5], (KV_LORA_RANK, MLA_HEADS * (MLA_NOPE_DIM + MLA_V_DIM)), f32) * KV_LORA_RANK ** -0.5
    w_out = jax.random.normal(ks[6], (MIX_WIDTH, D_MODEL), f32) * (MIX_WIDTH ** -0.5) * DEEPNORM_BETA
    ln_g = 1.0 + 0.02 * jax.random.normal(ks[7], (D_MODEL,), f32)
    ln_b = 0.02 * jax.random.normal(ks[8], (D_MODEL,), f32)
    return {"x": x, "w_in": w_in, "q_norm_g": q_norm_g, "kv_norm_g": kv_norm_g, "w_uq": w_uq,
            "w_ukv": w_ukv, "w_out": w_out, "ln_g": ln_g, "ln_b": ln_b}


def reference(x, w_in, q_norm_g, kv_norm_g, w_uq, w_ukv, w_out, ln_g, ln_b):
    offs = np.cumsum(IN_SPLITS)[:-1].tolist()
    for _ in range(DEPTH):
        h = x @ w_in
        c_q, c_kv, k_rope, g_a, q_b, k_b, v_b, g_b = jnp.split(h, offs, axis=-1)
        y_a = mla_attention(c_q, c_kv, k_rope, q_norm_g, kv_norm_g, w_uq, w_ukv) * jax.nn.silu(g_a)
        y_b = dilated_attention(q_b, k_b, v_b) * jax.nn.silu(g_b)
        mix = jnp.concatenate([y_a, y_b], axis=-1)
        x = layernorm(DEEPNORM_ALPHA * x + mix @ w_out, ln_g, ln_b)
    return x
```

```cpp
#include <hip/hip_runtime.h>
#include <hip/hip_cooperative_groups.h>
#include <cstdio>
namespace cg = cooperative_groups;

#define DI __device__ __forceinline__
#define LAS __attribute__((address_space(3)))
typedef unsigned short bf16_t;
typedef short bf16x8 __attribute__((ext_vector_type(8)));
typedef short s16x4 __attribute__((ext_vector_type(4)));
typedef float f32x16 __attribute__((ext_vector_type(16)));
typedef float f32x4 __attribute__((ext_vector_type(4)));
typedef float f32x2 __attribute__((ext_vector_type(2)));
typedef unsigned u32x4 __attribute__((ext_vector_type(4)));
typedef unsigned u32x2 __attribute__((ext_vector_type(2)));
typedef __bf16 bf2_t __attribute__((ext_vector_type(2)));

constexpr int T = 16384, SEQ = 4096, DM = 1024, INW = 3232, INWP = 3328;
constexpr int NTHREADS = 256;
constexpr int LDS_BYTES = 65536 + 1024;
constexpr int LDS_TAIL = 65536;
constexpr float LOG2E = 1.4426950408889634f;
constexpr float QA_SCALE = 0.10206207261596575f * 1.4426950408889634f;
constexpr float QB_SCALE = 0.125f * 1.4426950408889634f;
constexpr float DN_ALPHA = 1.189207115002721f;
constexpr float NEGBIG = -1e30f;

constexpr size_t SZ_XB = (size_t)T * 1024 * 2, SZ_CQ = (size_t)T * 384 * 2, SZ_CKV = (size_t)T * 256 * 2;
constexpr size_t WS_XB = 0;
constexpr size_t WS_CQ = WS_XB + SZ_XB;
constexpr size_t WS_CKV = WS_CQ + SZ_CQ;
constexpr size_t WS_OPART = 0;
constexpr size_t WS_WINT = WS_CKV + SZ_CKV;
constexpr size_t WS_WUQT = WS_WINT + (size_t)INWP * 1024 * 2;
constexpr size_t WS_WUKVT = WS_WUQT + (size_t)768 * 384 * 2;
constexpr size_t WS_WOUTT = WS_WUKVT + (size_t)1024 * 256 * 2;
constexpr size_t WS_CSA = WS_WOUTT + (size_t)1024 * 1024 * 2;
constexpr size_t WS_CSB = WS_CSA + (size_t)4096 * 16 * 8;
constexpr size_t WS_QA = WS_CSB + (size_t)4096 * 8 * 8;
constexpr size_t WS_KA = WS_QA + (size_t)T * 768 * 2;
constexpr size_t WS_VA = WS_KA + (size_t)T * 768 * 2;
constexpr size_t WS_GA = WS_VA + (size_t)T * 512 * 2;
constexpr size_t WS_GB = WS_GA + (size_t)T * 512 * 2;
constexpr size_t WS_QB = WS_GB + (size_t)T * 512 * 2;
constexpr size_t WS_KB = WS_QB + (size_t)T * 512 * 2;
constexpr size_t WS_VB = WS_KB + (size_t)T * 512 * 2;
constexpr size_t WS_MIX = WS_VB + (size_t)T * 512 * 2;
constexpr size_t WS_LSE = WS_MIX + (size_t)T * 1024 * 2;
constexpr size_t WS_CTR = WS_LSE + (size_t)3 * T * 8 * 4;
constexpr size_t WS_END = WS_CTR + 256;

struct Params {
    const float* x; const float* w_in; const float* qg; const float* kvg; const float* w_uq; const float* w_ukv; const float* w_out; const float* ln_g; const float* ln_b;
    float* out; unsigned char* ws;
};

DI int crow(int i, int h) { return (i & 3) + 8 * (i >> 2) + 4 * h; }
DI unsigned pk2(float lo, float hi) { bf2_t v = {(__bf16)lo, (__bf16)hi}; return __builtin_bit_cast(unsigned, v); }
DI bf16_t f2bf(float x) { __bf16 v = (__bf16)x; return __builtin_bit_cast(unsigned short, v); }
DI float bf_lo(unsigned u) { return __uint_as_float(u << 16); }
DI float bf_hi(unsigned u) { return __uint_as_float(u & 0xffff0000u); }
DI float silu(float x) { return x * __builtin_amdgcn_rcpf(1.f + __builtin_amdgcn_exp2f(-x * LOG2E)); }
DI f32x16 zero16() { f32x16 z; for (int i = 0; i < 16; ++i) z[i] = 0.f; return z; }
#define MFMA(a, b, c) __builtin_amdgcn_mfma_f32_32x32x16_bf16((a), (b), (c), 0, 0, 0)

DI int sw128(int r, int c) { return r * 128 + ((c ^ ((r >> 1) & 7)) << 4); }
DI int sw64(int r, int c) { return r * 64 + ((c ^ ((r >> 2) & 3)) << 4); }
DI int swV(int r, int c) { return r * 128 + ((c ^ (((r >> 1) & 1) << 2)) << 4); }

DI bf16x8 lds_r128(const char* p) { return *(const bf16x8*)p; }
DI s16x4 lds_tr(const char* p) { return __builtin_amdgcn_ds_read_tr16_b64_v4i16((LAS s16x4*)(p)); }

DI bf16x8 pack8(const f32x16& x, int s) {
    u32x4 p;
    p[0] = pk2(x[8 * s + 0], x[8 * s + 1]); p[1] = pk2(x[8 * s + 2], x[8 * s + 3]);
    p[2] = pk2(x[8 * s + 4], x[8 * s + 5]); p[3] = pk2(x[8 * s + 6], x[8 * s + 7]);
    return __builtin_bit_cast(bf16x8, p);
}

template <class Epi>
DI void gemm_tile(const bf16_t* __restrict__ A, int lda, const bf16_t* __restrict__ Bt, int ldb, int K, int row0, int col0, char* lds, const Epi& epi) {
    const int tid = threadIdx.x, lane = tid & 63, wid = tid >> 6;
    const int wm = wid >> 1, wn = wid & 1, r = lane & 31, h = lane >> 5;
    const int lrow = tid >> 3, lc = tid & 7;
    const bf16_t* ga = A + (size_t)(row0 + lrow) * lda + lc * 8;
    const bf16_t* gb = Bt + (size_t)(col0 + lrow) * ldb + lc * 8;
    u32x4 ra[4], rb[4];
#pragma unroll
    for (int i = 0; i < 4; ++i) { ra[i] = *(const u32x4*)(ga + (size_t)i * 32 * lda); rb[i] = *(const u32x4*)(gb + (size_t)i * 32 * ldb); }
    f32x16 acc[2][2];
#pragma unroll
    for (int a = 0; a < 2; ++a)
#pragma unroll
        for (int b = 0; b < 2; ++b) acc[a][b] = zero16();
    const int nk = K >> 6;
    for (int kt = 0; kt < nk; ++kt) {
        char* bufA = lds + (kt & 1) * 32768; char* bufB = bufA + 16384;
#pragma unroll
        for (int i = 0; i < 4; ++i) { const int row = lrow + 32 * i; *(u32x4*)(bufA + sw128(row, lc)) = ra[i]; *(u32x4*)(bufB + sw128(row, lc)) = rb[i]; }
        __syncthreads();
        if (kt + 1 < nk) {
#pragma unroll
            for (int i = 0; i < 4; ++i) { ra[i] = *(const u32x4*)(ga + (size_t)i * 32 * lda + (kt + 1) * 64); rb[i] = *(const u32x4*)(gb + (size_t)i * 32 * ldb + (kt + 1) * 64); }
        }
#pragma unroll
        for (int ks = 0; ks < 4; ++ks) {
            bf16x8 af[2], bfr[2];
#pragma unroll
            for (int mt = 0; mt < 2; ++mt) af[mt] = lds_r128(bufA + sw128(wm * 64 + mt * 32 + r, 2 * ks + h));
#pragma unroll
            for (int nt = 0; nt < 2; ++nt) bfr[nt] = lds_r128(bufB + sw128(wn * 64 + nt * 32 + r, 2 * ks + h));
#pragma unroll
            for (int mt = 0; mt < 2; ++mt)
#pragma unroll
                for (int nt = 0; nt < 2; ++nt) acc[mt][nt] = MFMA(af[mt], bfr[nt], acc[mt][nt]);
        }
    }
#pragma unroll
    for (int mt = 0; mt < 2; ++mt)
#pragma unroll
        for (int nt = 0; nt < 2; ++nt) epi(acc[mt][nt], row0 + wm * 64 + mt * 32, col0 + wn * 64 + nt * 32, lane);
    __syncthreads();
}

struct Epi1 {
    bf16_t *cq, *ckv, *Ka, *gA, *Qb, *Kb, *Vb, *gB; const f32x2* csA; const f32x2* csB;
    DI void operator()(const f32x16& acc, int tok0, int c0, int lane) const {
        if (c0 >= INW) return;
        const int r = lane & 31, h = lane >> 5;
        if (c0 < 640) {
            bf16_t* dst; int ld, cc;
            if (c0 < 384) { dst = cq; ld = 384; cc = c0; } else { dst = ckv; ld = 256; cc = c0 - 384; }
#pragma unroll
            for (int i = 0; i < 16; ++i) dst[(size_t)(tok0 + crow(i, h)) * ld + cc + r] = f2bf(acc[i]);
        } else if (c0 == 640) {
#pragma unroll
            for (int i = 0; i < 16; ++i) {
                const int tok = tok0 + crow(i, h); const float v = acc[i]; const float pv = __shfl_xor(v, 16);
                const f32x2 cs = csA[(tok & (SEQ - 1)) * 16 + (r & 15)];
                const float o = (r < 16) ? (v * cs.x - pv * cs.y) : (pv * cs.y + v * cs.x);
                const bf16_t ob = f2bf(o);
#pragma unroll
                for (int hh = 0; hh < 8; ++hh) Ka[(size_t)tok * 768 + hh * 96 + 64 + r] = ob;
            }
        } else if (c0 < 1184 || c0 >= 2720) {
            bf16_t* dst = (c0 < 1184) ? gA : gB; const int cc = (c0 < 1184) ? c0 - 672 : c0 - 2720;
#pragma unroll
            for (int i = 0; i < 16; ++i) dst[(size_t)(tok0 + crow(i, h)) * 512 + cc + r] = f2bf(silu(acc[i]));
        } else if (c0 < 2208) {
            const bool isq = c0 < 1696; bf16_t* dst = isq ? Qb : Kb; const int cc = isq ? c0 - 1184 : c0 - 1696; const float sc = isq ? QB_SCALE : 1.f;
            if ((cc & 63) == 0) {
#pragma unroll
                for (int i = 0; i < 16; ++i) {
                    const int tok = tok0 + crow(i, h); const float v = acc[i]; const float pv = __shfl_xor(v, 8);
                    const f32x2 cs = csB[(tok & (SEQ - 1)) * 8 + (r & 7)];
                    float o = (r < 8) ? (v * cs.x - pv * cs.y) : (pv * cs.y + v * cs.x);
                    if (r >= 16) o = v;
                    dst[(size_t)tok * 512 + cc + r] = f2bf(o * sc);
                }
            } else {
#pragma unroll
                for (int i = 0; i < 16; ++i) dst[(size_t)(tok0 + crow(i, h)) * 512 + cc + r] = f2bf(acc[i] * sc);
            }
        } else {
            const int cc = c0 - 2208;
#pragma unroll
            for (int i = 0; i < 16; ++i) Vb[(size_t)(tok0 + crow(i, h)) * 512 + cc + r] = f2bf(acc[i]);
        }
    }
};

struct EpiQ {
    bf16_t* Qa; const f32x2* csA; const float* rs; int row0;
    DI void operator()(const f32x16& acc, int tok0, int c0, int lane) const {
        const int r = lane & 31, h = lane >> 5;
        const bool rope = (c0 % 96) == 64;
#pragma unroll
        for (int i = 0; i < 16; ++i) {
            const int tok = tok0 + crow(i, h); const float v = acc[i] * rs[tok - row0];
            float o = v;
            if (rope) {
                const float pv = __shfl_xor(v, 16);
                const f32x2 cs = csA[(tok & (SEQ - 1)) * 16 + (r & 15)];
                o = (r < 16) ? (v * cs.x - pv * cs.y) : (pv * cs.y + v * cs.x);
            }
            Qa[(size_t)tok * 768 + c0 + r] = f2bf(o * QA_SCALE);
        }
    }
};
struct EpiKV {
    bf16_t *Ka, *Va; const float* rs; int row0;
    DI void operator()(const f32x16& acc, int tok0, int c0, int lane) const {
        const int r = lane & 31, h = lane >> 5;
        const int hh = c0 >> 7, w = c0 & 127;
        bf16_t* dst; int ld;
        if (w < 64) { dst = Ka + hh * 96 + w; ld = 768; } else { dst = Va + hh * 64 + (w - 64); ld = 512; }
#pragma unroll
        for (int i = 0; i < 16; ++i) { const int tok = tok0 + crow(i, h); dst[(size_t)tok * ld + r] = f2bf(acc[i] * rs[tok - row0]); }
    }
};
struct EpiOut {
    const float* x; float* out;
    DI void operator()(const f32x16& acc, int tok0, int c0, int lane) const {
        const int r = lane & 31, h = lane >> 5;
#pragma unroll
        for (int i = 0; i < 16; ++i) { const size_t o = (size_t)(tok0 + crow(i, h)) * DM + c0 + r; out[o] = DN_ALPHA * x[o] + acc[i]; }
    }
};

DI void row_rms(const bf16_t* A, int K, int row0, float* rs) {
    const int tid = threadIdx.x, row = tid >> 1, half = tid & 1;
    const int nch = K >> 4;
    const u32x4* p = (const u32x4*)(A + (size_t)(row0 + row) * K + half * (K >> 1));
    float s = 0.f;
    for (int c = 0; c < nch; ++c) {
        const u32x4 v = p[c];
#pragma unroll
        for (int j = 0; j < 4; ++j) { const float a = bf_lo(v[j]), b = bf_hi(v[j]); s += a * a + b * b; }
    }
    s += __shfl_xor(s, 1);
    if (half == 0) rs[row] = __builtin_amdgcn_rsqf(s / (float)K + 1e-6f);
    __syncthreads();
}

DI void mla_item(const Params& p, int b, int hh, int qb, char* lds) {
    const bf16_t* Qa = (const bf16_t*)(p.ws + WS_QA); const bf16_t* Ka = (const bf16_t*)(p.ws + WS_KA); const bf16_t* Va = (const bf16_t*)(p.ws + WS_VA);
    const bf16_t* gA = (const bf16_t*)(p.ws + WS_GA); bf16_t* mix = (bf16_t*)(p.ws + WS_MIX);
    const int tid = threadIdx.x, lane = tid & 63, wid = tid >> 6, r = lane & 31, h = lane >> 5;
    const size_t tokbase = (size_t)b * SEQ;
    const int q0 = qb * 128, qpos = q0 + wid * 32 + r;
    bf16x8 qf[6];
    { const bf16_t* qrow = Qa + (tokbase + qpos) * 768 + hh * 96 + 8 * h;
#pragma unroll
      for (int s = 0; s < 6; ++s) qf[s] = *(const bf16x8*)(qrow + 16 * s); }
    int kg[3], kl[3];
#pragma unroll
    for (int i = 0; i < 3; ++i) { const int c = tid + 256 * i, key = c / 12, cc = c - key * 12; kg[i] = key * 768 + cc * 8; kl[i] = (cc < 8) ? sw128(key, cc) : (8192 + sw64(key, cc - 8)); }
    int vg[2], vl[2];
#pragma unroll
    for (int i = 0; i < 2; ++i) { const int key = (tid >> 3) + 32 * i, cc = tid & 7; vg[i] = key * 512 + cc * 8; vl[i] = 12288 + swV(key, cc); }
    const bf16_t* kbase = Ka + tokbase * 768 + hh * 96;
    const bf16_t* vbase = Va + tokbase * 512 + hh * 64;
    const int tp = lane & 3, tq = (lane >> 2) & 3, tblk = (lane >> 4) & 1;
    const int vswz = ((tq >> 1) & 1) << 2;

    f32x16 o[2]; o[0] = zero16(); o[1] = zero16();
    float m = NEGBIG, l = 0.f;
    const int ntiles = 2 * qb + 2;
    u32x4 rk[3], rv[2];
#pragma unroll
    for (int i = 0; i < 3; ++i) rk[i] = *(const u32x4*)(kbase + kg[i]);
#pragma unroll
    for (int i = 0; i < 2; ++i) rv[i] = *(const u32x4*)(vbase + vg[i]);
    for (int t = 0; t < ntiles; ++t) {
        char* st = lds + (t & 1) * 20480;
#pragma unroll
        for (int i = 0; i < 3; ++i) *(u32x4*)(st + kl[i]) = rk[i];
#pragma unroll
        for (int i = 0; i < 2; ++i) *(u32x4*)(st + vl[i]) = rv[i];
        __syncthreads();
        if (t + 1 < ntiles) {
            const size_t ko = (size_t)(t + 1) * 64 * 768, vo = (size_t)(t + 1) * 64 * 512;
#pragma unroll
            for (int i = 0; i < 3; ++i) rk[i] = *(const u32x4*)(kbase + ko + kg[i]);
#pragma unroll
            for (int i = 0; i < 2; ++i) rv[i] = *(const u32x4*)(vbase + vo + vg[i]);
        }
        const int k0 = t * 64;
        if (k0 <= q0 + wid * 32 + 31) {
            f32x16 s[2];
#pragma unroll
            for (int kt = 0; kt < 2; ++kt) {
                s[kt] = zero16();
                const int kr = kt * 32 + r;
#pragma unroll
                for (int ss = 0; ss < 6; ++ss) {
                    const bf16x8 kf = (ss < 4) ? lds_r128(st + sw128(kr, 2 * ss + h)) : lds_r128(st + 8192 + sw64(kr, 2 * (ss - 4) + h));
                    s[kt] = MFMA(kf, qf[ss], s[kt]);
                }
            }
            if (k0 + 63 > q0 + wid * 32) {
#pragma unroll
                for (int kt = 0; kt < 2; ++kt)
#pragma unroll
                    for (int i = 0; i < 16; ++i) { const int key = k0 + kt * 32 + crow(i, h); if (key > qpos) s[kt][i] = NEGBIG; }
            }
            float mx = s[0][0];
#pragma unroll
            for (int kt = 0; kt < 2; ++kt)
#pragma unroll
                for (int i = 0; i < 16; ++i) mx = fmaxf(mx, s[kt][i]);
            mx = fmaxf(mx, __shfl_xor(mx, 32));
            const float mnew = fmaxf(m, mx);
            const float alpha = __builtin_amdgcn_exp2f(m - mnew);
            float ps = 0.f;
#pragma unroll
            for (int kt = 0; kt < 2; ++kt)
#pragma unroll
                for (int i = 0; i < 16; ++i) { const float e = __builtin_amdgcn_exp2f(s[kt][i] - mnew); s[kt][i] = e; ps += e; }
            ps += __shfl_xor(ps, 32);
            l = l * alpha + ps; m = mnew;
#pragma unroll
            for (int dt = 0; dt < 2; ++dt)
#pragma unroll
                for (int i = 0; i < 16; ++i) o[dt][i] *= alpha;
#pragma unroll
            for (int kt = 0; kt < 2; ++kt)
#pragma unroll
                for (int ss = 0; ss < 2; ++ss) {
                    const bf16x8 pb = pack8(s[kt], ss);
                    const int key_lo = kt * 32 + 16 * ss + 4 * h + tq;
#pragma unroll
                    for (int dt = 0; dt < 2; ++dt) {
                        const int ch = (dt * 4 + 2 * tblk + (tp >> 1)) ^ vswz;
                        const char* a0 = st + 12288 + key_lo * 128 + (ch << 4) + 8 * (tp & 1);
                        const s16x4 lo = lds_tr(a0), hi = lds_tr(a0 + 8 * 128);
                        const bf16x8 vf = __builtin_shufflevector(lo, hi, 0, 1, 2, 3, 4, 5, 6, 7);
                        o[dt] = MFMA(vf, pb, o[dt]);
                    }
                }
        }
    }
    const float inv = 1.f / l;
    const size_t tok = tokbase + qpos;
#pragma unroll
    for (int dt = 0; dt < 2; ++dt)
#pragma unroll
        for (int g = 0; g < 4; ++g) {
            const int dv = dt * 32 + 8 * g + 4 * h;
            const u32x2 gv = *(const u32x2*)(gA + tok * 512 + hh * 64 + dv);
            u32x2 w;
            w[0] = pk2(o[dt][4 * g + 0] * inv * bf_lo(gv[0]), o[dt][4 * g + 1] * inv * bf_hi(gv[0]));
            w[1] = pk2(o[dt][4 * g + 2] * inv * bf_lo(gv[1]), o[dt][4 * g + 3] * inv * bf_hi(gv[1]));
            *(u32x2*)(mix + tok * 1024 + hh * 64 + dv) = w;
        }
    __syncthreads();
}

DI void dil_item(const Params& p, int br, int b, int hh, int res, int nb, char* lds) {
    const bf16_t* Qb = (const bf16_t*)(p.ws + WS_QB); const bf16_t* Kb = (const bf16_t*)(p.ws + WS_KB); const bf16_t* Vb = (const bf16_t*)(p.ws + WS_VB);
    bf16_t* opart = (bf16_t*)(p.ws + WS_OPART); float* lse = (float*)(p.ws + WS_LSE);
    const int tid = threadIdx.x, lane = tid & 63, wid = tid >> 6, r = lane & 31, h = lane >> 5;
    const int d = (br == 0) ? 1 : ((br == 1) ? 4 : 16);
    const size_t tokbase = (size_t)b * SEQ;
    {
        const int cc = tid & 7, kkb = tid >> 3;
        u32x4 rk[8], rv[8];
#pragma unroll
        for (int i = 0; i < 8; ++i) {
            const int kk = kkb + 32 * i, km = 128 * (nb - 1) + kk;
            if (km >= 0) {
                const size_t off = (tokbase + (size_t)km * d + res) * 512 + hh * 64 + cc * 8;
                rk[i] = *(const u32x4*)(Kb + off); rv[i] = *(const u32x4*)(Vb + off);
            } else { rk[i] = (u32x4){0u, 0u, 0u, 0u}; rv[i] = (u32x4){0u, 0u, 0u, 0u}; }
        }
#pragma unroll
        for (int i = 0; i < 8; ++i) { const int kk = kkb + 32 * i; *(u32x4*)(lds + sw128(kk, cc)) = rk[i]; *(u32x4*)(lds + 32768 + swV(kk, cc)) = rv[i]; }
    }
    const int qm = 128 * nb + wid * 32 + r;
    const size_t qtok = tokbase + (size_t)qm * d + res;
    bf16x8 qf[4];
    { const bf16_t* qrow = Qb + qtok * 512 + hh * 64 + 8 * h;
#pragma unroll
      for (int s = 0; s < 4; ++s) qf[s] = *(const bf16x8*)(qrow + 16 * s); }
    __syncthreads();
    f32x16 s[5];
#pragma unroll
    for (int u = 0; u < 5; ++u) {
        const bool skip = (nb == 0) && (wid + u < 4);
        if (!skip) {
            s[u] = zero16();
            const int kr = 32 * (wid + u) + r;
#pragma unroll
            for (int ss = 0; ss < 4; ++ss) s[u] = MFMA(lds_r128(lds + sw128(kr, 2 * ss + h)), qf[ss], s[u]);
        } else {
#pragma unroll
            for (int i = 0; i < 16; ++i) s[u][i] = NEGBIG;
        }
    }
#pragma unroll
    for (int i = 0; i < 16; ++i) { const int j = crow(i, h); if (j < r) s[0][i] = NEGBIG; if (j > r) s[4][i] = NEGBIG; }
    float mx = s[0][0];
#pragma unroll
    for (int u = 0; u < 5; ++u)
#pragma unroll
        for (int i = 0; i < 16; ++i) mx = fmaxf(mx, s[u][i]);
    mx = fmaxf(mx, __shfl_xor(mx, 32));
    float l = 0.f;
#pragma unroll
    for (int u = 0; u < 5; ++u)
#pragma unroll
        for (int i = 0; i < 16; ++i) { const float e = __builtin_amdgcn_exp2f(s[u][i] - mx); s[u][i] = e; l += e; }
    l += __shfl_xor(l, 32);
    f32x16 o[2]; o[0] = zero16(); o[1] = zero16();
    const int tp = lane & 3, tq = (lane >> 2) & 3, tblk = (lane >> 4) & 1;
    const int vswz = ((tq >> 1) & 1) << 2;
#pragma unroll
    for (int u = 0; u < 5; ++u) {
        const bool skip = (nb == 0) && (wid + u < 4);
        if (!skip) {
#pragma unroll
            for (int ss = 0; ss < 2; ++ss) {
                const bf16x8 pb = pack8(s[u], ss);
                const int key_lo = 32 * (wid + u) + 16 * ss + 4 * h + tq;
#pragma unroll
                for (int dt = 0; dt < 2; ++dt) {
                    const int ch = (dt * 4 + 2 * tblk + (tp >> 1)) ^ vswz;
                    const char* a0 = lds + 32768 + key_lo * 128 + (ch << 4) + 8 * (tp & 1);
                    const s16x4 lo = lds_tr(a0), hi = lds_tr(a0 + 8 * 128);
                    const bf16x8 vf = __builtin_shufflevector(lo, hi, 0, 1, 2, 3, 4, 5, 6, 7);
                    o[dt] = MFMA(vf, pb, o[dt]);
                }
            }
        }
    }
    const float inv = 1.f / l;
    bf16_t* op = opart + ((size_t)br * T + qtok) * 512 + hh * 64;
#pragma unroll
    for (int dt = 0; dt < 2; ++dt)
#pragma unroll
        for (int g = 0; g < 4; ++g) {
            const int dv = dt * 32 + 8 * g + 4 * h;
            u32x2 w;
            w[0] = pk2(o[dt][4 * g + 0] * inv, o[dt][4 * g + 1] * inv);
            w[1] = pk2(o[dt][4 * g + 2] * inv, o[dt][4 * g + 3] * inv);
            *(u32x2*)(op + dv) = w;
        }
    if (h == 0) lse[((size_t)br * T + qtok) * 8 + hh] = mx + __builtin_amdgcn_logf(l);
    __syncthreads();
}

DI void phase0(const Params& p) {
    const size_t gtid = (size_t)blockIdx.x * NTHREADS + threadIdx.x, gsz = (size_t)gridDim.x * NTHREADS;
    if (gtid == 0) *(unsigned*)(p.ws + WS_CTR) = 0u;
    { u32x4* xb = (u32x4*)(p.ws + WS_XB); const f32x4* x4 = (const f32x4*)p.x;
      for (size_t i = gtid; i < (size_t)T * 1024 / 8; i += gsz) { const f32x4 a = x4[2 * i], b = x4[2 * i + 1]; u32x4 w; w[0] = pk2(a[0], a[1]); w[1] = pk2(a[2], a[3]); w[2] = pk2(b[0], b[1]); w[3] = pk2(b[2], b[3]); xb[i] = w; } }
    { bf16_t* wt = (bf16_t*)(p.ws + WS_WINT);
      for (size_t i = gtid; i < (size_t)INWP * 128; i += gsz) { const int n = (int)(i % INWP), k8 = (int)(i / INWP); float v[8];
#pragma unroll
        for (int j = 0; j < 8; ++j) v[j] = (n < INW) ? p.w_in[(size_t)(k8 * 8 + j) * INW + n] : 0.f;
        u32x4 w; w[0] = pk2(v[0], v[1]); w[1] = pk2(v[2], v[3]); w[2] = pk2(v[4], v[5]); w[3] = pk2(v[6], v[7]); *(u32x4*)(wt + (size_t)n * 1024 + k8 * 8) = w; } }
    { bf16_t* wt = (bf16_t*)(p.ws + WS_WUQT);
      for (size_t i = gtid; i < (size_t)768 * 48; i += gsz) { const int n = (int)(i % 768), k8 = (int)(i / 768); float v[8];
#pragma unroll
        for (int j = 0; j < 8; ++j) v[j] = p.w_uq[(size_t)(k8 * 8 + j) * 768 + n] * p.qg[k8 * 8 + j];
        u32x4 w; w[0] = pk2(v[0], v[1]); w[1] = pk2(v[2], v[3]); w[2] = pk2(v[4], v[5]); w[3] = pk2(v[6], v[7]); *(u32x4*)(wt + (size_t)n * 384 + k8 * 8) = w; } }
    { bf16_t* wt = (bf16_t*)(p.ws + WS_WUKVT);
      for (size_t i = gtid; i < (size_t)1024 * 32; i += gsz) { const int n = (int)(i % 1024), k8 = (int)(i / 1024); float v[8];
#pragma unroll
        for (int j = 0; j < 8; ++j) v[j] = p.w_ukv[(size_t)(k8 * 8 + j) * 1024 + n] * p.kvg[k8 * 8 + j];
        u32x4 w; w[0] = pk2(v[0], v[1]); w[1] = pk2(v[2], v[3]); w[2] = pk2(v[4], v[5]); w[3] = pk2(v[6], v[7]); *(u32x4*)(wt + (size_t)n * 256 + k8 * 8) = w; } }
    { bf16_t* wt = (bf16_t*)(p.ws + WS_WOUTT);
      for (size_t i = gtid; i < (size_t)1024 * 128; i += gsz) { const int n = (int)(i % 1024), k8 = (int)(i / 1024); float v[8];
#pragma unroll
        for (int j = 0; j < 8; ++j) v[j] = p.w_out[(size_t)(k8 * 8 + j) * 1024 + n];
        u32x4 w; w[0] = pk2(v[0], v[1]); w[1] = pk2(v[2], v[3]); w[2] = pk2(v[4], v[5]); w[3] = pk2(v[6], v[7]); *(u32x4*)(wt + (size_t)n * 1024 + k8 * 8) = w; } }
    { f32x2* csA = (f32x2*)(p.ws + WS_CSA); f32x2* csB = (f32x2*)(p.ws + WS_CSB);
      for (size_t i = gtid; i < (size_t)SEQ * 24; i += gsz) {
          int pos, f, dim; f32x2* dst;
          if (i < (size_t)SEQ * 16) { pos = (int)(i >> 4); f = (int)(i & 15); dim = 32; dst = csA + i; } else { const size_t j = i - (size_t)SEQ * 16; pos = (int)(j >> 3); f = (int)(j & 7); dim = 16; dst = csB + j; }
          const float invf = __builtin_exp2f(-(float)(2 * f) / (float)dim * 18.931568569324174f);
          const float ang = (float)pos * invf;
          const double rev = (double)ang * 0.15915494309189535;
          const float fr = (float)(rev - __builtin_rint(rev));
          *dst = (f32x2){__builtin_amdgcn_cosf(fr), __builtin_amdgcn_sinf(fr)};
      } }
}

DI int vblock() { const int per = gridDim.x >> 3; return (blockIdx.x & 7) * per + (blockIdx.x >> 3); }

DI void phase1(const Params& p, char* lds) {
    Epi1 e; e.cq = (bf16_t*)(p.ws + WS_CQ); e.ckv = (bf16_t*)(p.ws + WS_CKV); e.Ka = (bf16_t*)(p.ws + WS_KA); e.gA = (bf16_t*)(p.ws + WS_GA);
    e.Qb = (bf16_t*)(p.ws + WS_QB); e.Kb = (bf16_t*)(p.ws + WS_KB); e.Vb = (bf16_t*)(p.ws + WS_VB); e.gB = (bf16_t*)(p.ws + WS_GB);
    e.csA = (const f32x2*)(p.ws + WS_CSA); e.csB = (const f32x2*)(p.ws + WS_CSB);
    const bf16_t* xb = (const bf16_t*)(p.ws + WS_XB); const bf16_t* wt = (const bf16_t*)(p.ws + WS_WINT);
    constexpr int NC = INWP / 128, NT = (T / 128) * NC;
    for (int t = vblock(); t < NT; t += gridDim.x) { const int rt = t / NC, ct = t - rt * NC; gemm_tile(xb, 1024, wt, 1024, 1024, rt * 128, ct * 128, lds, e); }
}

DI void phase2(const Params& p, char* lds) {
    float* rs = (float*)(lds + LDS_TAIL);
    const bf16_t* cq = (const bf16_t*)(p.ws + WS_CQ); const bf16_t* ckv = (const bf16_t*)(p.ws + WS_CKV);
    constexpr int NQ = 128 * 6, NKV = 128 * 8;
    for (int t = vblock(); t < NQ + NKV; t += gridDim.x) {
        if (t < NQ) {
            const int rt = t / 6, ct = t - rt * 6;
            row_rms(cq, 384, rt * 128, rs);
            EpiQ e; e.Qa = (bf16_t*)(p.ws + WS_QA); e.csA = (const f32x2*)(p.ws + WS_CSA); e.rs = rs; e.row0 = rt * 128;
            gemm_tile(cq, 384, (const bf16_t*)(p.ws + WS_WUQT), 384, 384, rt * 128, ct * 128, lds, e);
        } else {
            const int u = t - NQ, rt = u >> 3, ct = u & 7;
            row_rms(ckv, 256, rt * 128, rs);
            EpiKV e; e.Ka = (bf16_t*)(p.ws + WS_KA); e.Va = (bf16_t*)(p.ws + WS_VA); e.rs = rs; e.row0 = rt * 128;
            gemm_tile(ckv, 256, (const bf16_t*)(p.ws + WS_WUKVT), 256, 256, rt * 128, ct * 128, lds, e);
        }
    }
}

DI void phase3(const Params& p, char* lds) {
    unsigned* ctr = (unsigned*)(p.ws + WS_CTR);
    int* slot = (int*)(lds + LDS_TAIL + 512);
    for (;;) {
        __syncthreads();
        if (threadIdx.x == 0) *slot = (int)atomicAdd(ctr, 1u);
        __syncthreads();
        const int it = *slot;
        if (it >= 4096) break;
        if (it < 1024) {
            const int qb = 31 - (it >> 5), bh = it & 31;
            mla_item(p, bh >> 3, bh & 7, qb, lds);
        } else {
            const int j = it - 1024, br = j >> 10, rem = j & 1023, bh = rem >> 5, w = rem & 31;
            const int nblk = (br == 0) ? 32 : ((br == 1) ? 8 : 2);
            const int res = w / nblk, nb = w - res * nblk;
            dil_item(p, br, bh >> 3, bh & 7, res, nb, lds);
        }
    }
}

DI void phase4(const Params& p) {
    const bf16_t* opart = (const bf16_t*)(p.ws + WS_OPART); const float* lse = (const float*)(p.ws + WS_LSE); const bf16_t* gB = (const bf16_t*)(p.ws + WS_GB);
    bf16_t* mix = (bf16_t*)(p.ws + WS_MIX);
    const size_t gtid = (size_t)blockIdx.x * NTHREADS + threadIdx.x, gsz = (size_t)gridDim.x * NTHREADS;
    for (size_t i = gtid; i < (size_t)T * 64; i += gsz) {
        const size_t tok = i >> 6; const int c8 = (int)(i & 63), hh = c8 >> 3;
        const float l0 = lse[tok * 8 + hh], l1 = lse[((size_t)T + tok) * 8 + hh], l2 = lse[((size_t)2 * T + tok) * 8 + hh];
        const float M = fmaxf(l0, fmaxf(l1, l2));
        float w0 = __builtin_amdgcn_exp2f(l0 - M), w1 = __builtin_amdgcn_exp2f(l1 - M), w2 = __builtin_amdgcn_exp2f(l2 - M);
        const float inv = 1.f / (w0 + w1 + w2); w0 *= inv; w1 *= inv; w2 *= inv;
        const u32x4 a = *(const u32x4*)(opart + tok * 512 + c8 * 8), b = *(const u32x4*)(opart + ((size_t)T + tok) * 512 + c8 * 8), c = *(const u32x4*)(opart + ((size_t)2 * T + tok) * 512 + c8 * 8);
        const u32x4 g = *(const u32x4*)(gB + tok * 512 + c8 * 8);
        u32x4 o;
#pragma unroll
        for (int j = 0; j < 4; ++j) {
            const float lo = (w0 * bf_lo(a[j]) + w1 * bf_lo(b[j]) + w2 * bf_lo(c[j])) * bf_lo(g[j]);
            const float hi = (w0 * bf_hi(a[j]) + w1 * bf_hi(b[j]) + w2 * bf_hi(c[j])) * bf_hi(g[j]);
            o[j] = pk2(lo, hi);
        }
        *(u32x4*)(mix + tok * 1024 + 512 + c8 * 8) = o;
    }
}

DI void phase5(const Params& p, char* lds) {
    EpiOut e; e.x = p.x; e.out = p.out;
    const bf16_t* mix = (const bf16_t*)(p.ws + WS_MIX); const bf16_t* wt = (const bf16_t*)(p.ws + WS_WOUTT);
    constexpr int NT = (T / 128) * 8;
    for (int t = vblock(); t < NT; t += gridDim.x) { const int rt = t >> 3, ct = t & 7; gemm_tile(mix, 1024, wt, 1024, 1024, rt * 128, ct * 128, lds, e); }
}

DI void phase6(const Params& p) {
    const int lane = threadIdx.x & 63, wid = threadIdx.x >> 6;
    const int gw = blockIdx.x * 4 + wid, nw = gridDim.x * 4;
    f32x4 g[4], bb[4];
#pragma unroll
    for (int j = 0; j < 4; ++j) { g[j] = *(const f32x4*)(p.ln_g + lane * 4 + 256 * j); bb[j] = *(const f32x4*)(p.ln_b + lane * 4 + 256 * j); }
    for (int row = gw; row < T; row += nw) {
        float* rp = p.out + (size_t)row * DM + lane * 4;
        f32x4 v[4]; float s = 0.f;
#pragma unroll
        for (int j = 0; j < 4; ++j) { v[j] = *(const f32x4*)(rp + 256 * j); s += (v[j][0] + v[j][1]) + (v[j][2] + v[j][3]); }
#pragma unroll
        for (int o = 32; o > 0; o >>= 1) s += __shfl_xor(s, o);
        const float mu = s * (1.f / 1024.f); float q = 0.f;
#pragma unroll
        for (int j = 0; j < 4; ++j) { v[j] = v[j] - mu; q += (v[j][0] * v[j][0] + v[j][1] * v[j][1]) + (v[j][2] * v[j][2] + v[j][3] * v[j][3]); }
#pragma unroll
        for (int o = 32; o > 0; o >>= 1) q += __shfl_xor(q, o);
        const float rstd = __builtin_amdgcn_rsqf(q * (1.f / 1024.f) + 1e-5f);
#pragma unroll
        for (int j = 0; j < 4; ++j) *(f32x4*)(rp + 256 * j) = v[j] * rstd * g[j] + bb[j];
    }
}

template <int LO, int HI>
__global__ void __launch_bounds__(NTHREADS, 2) fwd_megakernel(Params p) {
    extern __shared__ __attribute__((aligned(16))) char lds[];
    cg::grid_group grid = cg::this_grid();
    if constexpr (LO <= 0 && 0 < HI) { phase0(p); if constexpr (1 < HI) grid.sync(); }
    if constexpr (LO <= 1 && 1 < HI) { phase1(p, lds); if constexpr (2 < HI) grid.sync(); }
    if constexpr (LO <= 2 && 2 < HI) { phase2(p, lds); if constexpr (3 < HI) grid.sync(); }
    if constexpr (LO <= 3 && 3 < HI) { phase3(p, lds); if constexpr (4 < HI) grid.sync(); }
    if constexpr (LO <= 4 && 4 < HI) { phase4(p); if constexpr (5 < HI) grid.sync(); }
    if constexpr (LO <= 5 && 5 < HI) { phase5(p, lds); if constexpr (6 < HI) grid.sync(); }
    if constexpr (LO <= 6 && 6 < HI) { phase6(p); }
}

#ifndef N_LAUNCH
#define N_LAUNCH 1
#endif

extern "C" void kernel_launch(void* const* d_in, const int* in_sizes, int n_in, void* d_out, int out_size, void* d_ws, size_t ws_size, hipStream_t stream) {
    static int grid_blocks = 0;
    if (grid_blocks == 0) {
        if (n_in != 9 || ws_size < WS_END) { fprintf(stderr, "kernel_launch: unexpected n_in %d / ws %zu (need %zu)\n", n_in, ws_size, (size_t)WS_END); grid_blocks = -1; return; }
        int dev = 0, cus = 0, per_cu = 0;
        (void)hipGetDevice(&dev);
        (void)hipDeviceGetAttribute(&cus, hipDeviceAttributeMultiprocessorCount, dev);
#if N_LAUNCH == 1
        if (hipFuncSetAttribute((const void*)fwd_megakernel<0, 7>, hipFuncAttributeMaxDynamicSharedMemorySize, LDS_BYTES) != hipSuccess) { fprintf(stderr, "kernel_launch: hipFuncSetAttribute failed\n"); grid_blocks = -1; return; }
#else
        (void)hipFuncSetAttribute((const void*)fwd_megakernel<0, 1>, hipFuncAttributeMaxDynamicSharedMemorySize, LDS_BYTES);
        (void)hipFuncSetAttribute((const void*)fwd_megakernel<1, 2>, hipFuncAttributeMaxDynamicSharedMemorySize, LDS_BYTES);
        (void)hipFuncSetAttribute((const void*)fwd_megakernel<2, 3>, hipFuncAttributeMaxDynamicSharedMemorySize, LDS_BYTES);
        (void)hipFuncSetAttribute((const void*)fwd_megakernel<3, 4>, hipFuncAttributeMaxDynamicSharedMemorySize, LDS_BYTES);
        (void)hipFuncSetAttribute((const void*)fwd_megakernel<4, 5>, hipFuncAttributeMaxDynamicSharedMemorySize, LDS_BYTES);
        (void)hipFuncSetAttribute((const void*)fwd_megakernel<5, 6>, hipFuncAttributeMaxDynamicSharedMemorySize, LDS_BYTES);
        (void)hipFuncSetAttribute((const void*)fwd_megakernel<6, 7>, hipFuncAttributeMaxDynamicSharedMemorySize, LDS_BYTES);
#endif
        if (hipOccupancyMaxActiveBlocksPerMultiprocessor(&per_cu, (const void*)fwd_megakernel<0, 7>, NTHREADS, LDS_BYTES) != hipSuccess || per_cu < 1) { fprintf(stderr, "kernel_launch: occupancy query failed (%d)\n", per_cu); grid_blocks = -1; return; }
        if (per_cu > 2) per_cu = 2;
        grid_blocks = cus * per_cu;
        grid_blocks -= grid_blocks % 8;
        fprintf(stderr, "kernel_launch: cus %d per_cu %d grid %d\n", cus, per_cu, grid_blocks);
    }
    if (grid_blocks <= 0) return;
    Params p{};
    p.x = (const float*)d_in[0]; p.w_in = (const float*)d_in[1]; p.qg = (const float*)d_in[2]; p.kvg = (const float*)d_in[3]; p.w_uq = (const float*)d_in[4];
    p.w_ukv = (const float*)d_in[5]; p.w_out = (const float*)d_in[6]; p.ln_g = (const float*)d_in[7]; p.ln_b = (const float*)d_in[8];
    p.out = (float*)d_out; p.ws = (unsigned char*)d_ws;
#if N_LAUNCH == 1
    void* args[] = {&p};
    hipError_t e = hipLaunchCooperativeKernel((const void*)fwd_megakernel<0, 7>, dim3(grid_blocks), dim3(NTHREADS), args, LDS_BYTES, stream);
    if (e != hipSuccess) fprintf(stderr, "cooperative launch failed: %s (grid %d)\n", hipGetErrorString(e), grid_blocks);
#else
    hipLaunchKernelGGL((fwd_megakernel<0, 1>), dim3(grid_blocks), dim3(NTHREADS), LDS_BYTES, stream, p);
    hipLaunchKernelGGL((fwd_megakernel<1, 2>), dim3(grid_blocks), dim3(NTHREADS), LDS_BYTES, stream, p);
    hipLaunchKernelGGL((fwd_megakernel<2, 3>), dim3(grid_blocks), dim3(NTHREADS), LDS_BYTES, stream, p);
    hipLaunchKernelGGL((fwd_megakernel<3, 4>), dim3(grid_blocks), dim3(NTHREADS), LDS_BYTES, stream, p);
    hipLaunchKernelGGL((fwd_megakernel<4, 5>), dim3(grid_blocks), dim3(NTHREADS), LDS_BYTES, stream, p);
    hipLaunchKernelGGL((fwd_megakernel<5, 6>), dim3(grid_blocks), dim3(NTHREADS), LDS_BYTES, stream, p);
    hipLaunchKernelGGL((fwd_megakernel<6, 7>), dim3(grid_blocks), dim3(NTHREADS), LDS_BYTES, stream, p);
#endif
}
```

```cpp
#include <hip/hip_runtime.h>
#include <cstdio>

#define DI __device__ __forceinline__
#ifndef PROBE_DUP
#define PROBE_DUP 0
#endif
#define LAS __attribute__((address_space(3)))
typedef unsigned short bf16_t;
typedef short bf16x8 __attribute__((ext_vector_type(8)));
typedef short s16x4 __attribute__((ext_vector_type(4)));
typedef float f32x16 __attribute__((ext_vector_type(16)));
typedef float f32x4 __attribute__((ext_vector_type(4)));
typedef float f32x2 __attribute__((ext_vector_type(2)));
typedef unsigned u32x4 __attribute__((ext_vector_type(4)));
typedef unsigned u32x2 __attribute__((ext_vector_type(2)));
typedef __bf16 bf2_t __attribute__((ext_vector_type(2)));

constexpr int T = 16384, SEQ = 4096, DM = 1024, INW = 3232, INWP = 3328;
constexpr int NTHREADS = 256;
constexpr int LDS_BYTES = 65536 + 1024;
constexpr int LDS_TAIL = 65536;
constexpr float LOG2E = 1.4426950408889634f;
constexpr float QA_SCALE = 0.10206207261596575f * 1.4426950408889634f;
constexpr float QB_SCALE = 0.125f * 1.4426950408889634f;
constexpr float DN_ALPHA = 1.189207115002721f;
constexpr float NEGBIG = -1e30f;

constexpr size_t SZ_XB = (size_t)T * 1024 * 2, SZ_CQ = (size_t)T * 384 * 2, SZ_CKV = (size_t)T * 256 * 2;
constexpr size_t WS_XB = 0;
constexpr size_t WS_CQ = WS_XB + SZ_XB;
constexpr size_t WS_CKV = WS_CQ + SZ_CQ;
constexpr size_t WS_OPART = 0;
constexpr size_t WS_WINT = WS_CKV + SZ_CKV;
constexpr size_t WS_WUQT = WS_WINT + (size_t)INWP * 1024 * 2;
constexpr size_t WS_WUKVT = WS_WUQT + (size_t)768 * 384 * 2;
constexpr size_t WS_WOUTT = WS_WUKVT + (size_t)1024 * 256 * 2;
constexpr size_t WS_CSA = WS_WOUTT + (size_t)1024 * 1024 * 2;
constexpr size_t WS_CSB = WS_CSA + (size_t)4096 * 16 * 8;
constexpr size_t WS_QA = WS_CSB + (size_t)4096 * 8 * 8;
constexpr size_t WS_KA = WS_QA + (size_t)T * 768 * 2;
constexpr size_t WS_VA = WS_KA + (size_t)T * 768 * 2;
constexpr size_t WS_GA = WS_VA + (size_t)T * 512 * 2;
constexpr size_t WS_GB = WS_GA + (size_t)T * 512 * 2;
constexpr size_t WS_QB = WS_GB + (size_t)T * 512 * 2;
constexpr size_t WS_KB = WS_QB + (size_t)T * 512 * 2;
constexpr size_t WS_VB = WS_KB + (size_t)T * 512 * 2;
constexpr size_t WS_MIX = WS_VB + (size_t)T * 512 * 2;
constexpr size_t WS_LSE = WS_MIX + (size_t)T * 1024 * 2;
constexpr size_t WS_BAR = WS_LSE + (size_t)3 * T * 8 * 4;
constexpr size_t WS_CTR = WS_BAR + 3456 * 4;
constexpr size_t CTL_BYTES = 3456 * 4 + 256;
constexpr size_t WS_END = WS_CTR + 256;

struct Params {
    const float* x; const float* w_in; const float* qg; const float* kvg; const float* w_uq; const float* w_ukv; const float* w_out; const float* ln_g; const float* ln_b;
    float* out; unsigned char* ws;
};

DI int crow(int i, int h) { return (i & 3) + 8 * (i >> 2) + 4 * h; }
DI unsigned pk2(float lo, float hi) { bf2_t v = {(__bf16)lo, (__bf16)hi}; return __builtin_bit_cast(unsigned, v); }
DI bf16_t f2bf(float x) { __bf16 v = (__bf16)x; return __builtin_bit_cast(unsigned short, v); }
DI float bf_lo(unsigned u) { return __uint_as_float(u << 16); }
DI float bf_hi(unsigned u) { return __uint_as_float(u & 0xffff0000u); }
DI float silu(float x) { return x * __builtin_amdgcn_rcpf(1.f + __builtin_amdgcn_exp2f(-x * LOG2E)); }
DI f32x16 zero16() { f32x16 z; for (int i = 0; i < 16; ++i) z[i] = 0.f; return z; }
#define MFMA(a, b, c) __builtin_amdgcn_mfma_f32_32x32x16_bf16((a), (b), (c), 0, 0, 0)

DI int sw128(int r, int c) { return r * 128 + ((c ^ ((r >> 1) & 7)) << 4); }
DI int sw64(int r, int c) { return r * 64 + ((c ^ ((r >> 2) & 3)) << 4); }
DI int swV(int r, int c) { return r * 128 + ((c ^ (((r >> 1) & 1) << 2)) << 4); }

DI bf16x8 lds_r128(const char* p) { return *(const bf16x8*)p; }
DI s16x4 lds_tr(const char* p) { return __builtin_amdgcn_ds_read_tr16_b64_v4i16((LAS s16x4*)(p)); }

DI bf16x8 pack8(const f32x16& x, int s) {
    u32x4 p;
    p[0] = pk2(x[8 * s + 0], x[8 * s + 1]); p[1] = pk2(x[8 * s + 2], x[8 * s + 3]);
    p[2] = pk2(x[8 * s + 4], x[8 * s + 5]); p[3] = pk2(x[8 * s + 6], x[8 * s + 7]);
    return __builtin_bit_cast(bf16x8, p);
}

template <class Epi>
DI void gemm_tile(const bf16_t* __restrict__ A, int lda, const bf16_t* __restrict__ Bt, int ldb, int K, int row0, int col0, char* lds, const Epi& epi) {
    const int tid = threadIdx.x, lane = tid & 63, wid = tid >> 6;
    const int wm = wid >> 1, wn = wid & 1, r = lane & 31, h = lane >> 5;
    const int lrow = tid >> 3, lc = tid & 7;
    const bf16_t* ga = A + (size_t)(row0 + lrow) * lda + lc * 8;
    const bf16_t* gb = Bt + (size_t)(col0 + lrow) * ldb + lc * 8;
    u32x4 ra[4], rb[4];
#pragma unroll
    for (int i = 0; i < 4; ++i) { ra[i] = *(const u32x4*)(ga + (size_t)i * 32 * lda); rb[i] = *(const u32x4*)(gb + (size_t)i * 32 * ldb); }
    f32x16 acc[2][2];
#pragma unroll
    for (int a = 0; a < 2; ++a)
#pragma unroll
        for (int b = 0; b < 2; ++b) acc[a][b] = zero16();
    const int nk = K >> 6;
    for (int kt = 0; kt < nk; ++kt) {
        char* bufA = lds + (kt & 1) * 32768; char* bufB = bufA + 16384;
#pragma unroll
        for (int i = 0; i < 4; ++i) { const int row = lrow + 32 * i; *(u32x4*)(bufA + sw128(row, lc)) = ra[i]; *(u32x4*)(bufB + sw128(row, lc)) = rb[i]; }
        __syncthreads();
        if (kt + 1 < nk) {
#pragma unroll
            for (int i = 0; i < 4; ++i) { ra[i] = *(const u32x4*)(ga + (size_t)i * 32 * lda + (kt + 1) * 64); rb[i] = *(const u32x4*)(gb + (size_t)i * 32 * ldb + (kt + 1) * 64); }
        }
#pragma unroll
        for (int ks = 0; ks < 4; ++ks) {
            bf16x8 af[2], bfr[2];
#pragma unroll
            for (int mt = 0; mt < 2; ++mt) af[mt] = lds_r128(bufA + sw128(wm * 64 + mt * 32 + r, 2 * ks + h));
#pragma unroll
            for (int nt = 0; nt < 2; ++nt) bfr[nt] = lds_r128(bufB + sw128(wn * 64 + nt * 32 + r, 2 * ks + h));
#pragma unroll
            for (int mt = 0; mt < 2; ++mt)
#pragma unroll
                for (int nt = 0; nt < 2; ++nt) acc[mt][nt] = MFMA(af[mt], bfr[nt], acc[mt][nt]);
        }
    }
#pragma unroll
    for (int mt = 0; mt < 2; ++mt)
#pragma unroll
        for (int nt = 0; nt < 2; ++nt) epi(acc[mt][nt], row0 + wm * 64 + mt * 32, col0 + wn * 64 + nt * 32, lane);
    __syncthreads();
}

struct Epi1 {
    bf16_t *cq, *ckv, *Ka, *gA, *Qb, *Kb, *Vb, *gB; const f32x2* csA; const f32x2* csB;
    DI void operator()(const f32x16& acc, int tok0, int c0, int lane) const {
        if (c0 >= INW) return;
        const int r = lane & 31, h = lane >> 5;
        if (c0 < 640) {
            bf16_t* dst; int ld, cc;
            if (c0 < 384) { dst = cq; ld = 384; cc = c0; } else { dst = ckv; ld = 256; cc = c0 - 384; }
#pragma unroll
            for (int i = 0; i < 16; ++i) dst[(size_t)(tok0 + crow(i, h)) * ld + cc + r] = f2bf(acc[i]);
        } else if (c0 == 640) {
#pragma unroll
            for (int i = 0; i < 16; ++i) {
                const int tok = tok0 + crow(i, h); const float v = acc[i]; const float pv = __shfl_xor(v, 16);
                const f32x2 cs = csA[(tok & (SEQ - 1)) * 16 + (r & 15)];
                const float o = (r < 16) ? (v * cs.x - pv * cs.y) : (pv * cs.y + v * cs.x);
                const bf16_t ob = f2bf(o);
#pragma unroll
                for (int hh = 0; hh < 8; ++hh) Ka[(size_t)tok * 768 + hh * 96 + 64 + r] = ob;
            }
        } else if (c0 < 1184 || c0 >= 2720) {
            bf16_t* dst = (c0 < 1184) ? gA : gB; const int cc = (c0 < 1184) ? c0 - 672 : c0 - 2720;
#pragma unroll
            for (int i = 0; i < 16; ++i) dst[(size_t)(tok0 + crow(i, h)) * 512 + cc + r] = f2bf(silu(acc[i]));
        } else if (c0 < 2208) {
            const bool isq = c0 < 1696; bf16_t* dst = isq ? Qb : Kb; const int cc = isq ? c0 - 1184 : c0 - 1696; const float sc = isq ? QB_SCALE : 1.f;
            if ((cc & 63) == 0) {
#pragma unroll
                for (int i = 0; i < 16; ++i) {
                    const int tok = tok0 + crow(i, h); const float v = acc[i]; const float pv = __shfl_xor(v, 8);
                    const f32x2 cs = csB[(tok & (SEQ - 1)) * 8 + (r & 7)];
                    float o = (r < 8) ? (v * cs.x - pv * cs.y) : (pv * cs.y + v * cs.x);
                    if (r >= 16) o = v;
                    dst[(size_t)tok * 512 + cc + r] = f2bf(o * sc);
                }
            } else {
#pragma unroll
                for (int i = 0; i < 16; ++i) dst[(size_t)(tok0 + crow(i, h)) * 512 + cc + r] = f2bf(acc[i] * sc);
            }
        } else {
            const int cc = c0 - 2208;
#pragma unroll
            for (int i = 0; i < 16; ++i) Vb[(size_t)(tok0 + crow(i, h)) * 512 + cc + r] = f2bf(acc[i]);
        }
    }
};

struct EpiQ {
    bf16_t* Qa; const f32x2* csA; const float* rs; int row0;
    DI void operator()(const f32x16& acc, int tok0, int c0, int lane) const {
        const int r = lane & 31, h = lane >> 5;
        const bool rope = (c0 % 96) == 64;
#pragma unroll
        for (int i = 0; i < 16; ++i) {
            const int tok = tok0 + crow(i, h); const float v = acc[i] * rs[tok - row0];
            float o = v;
            if (rope) {
                const float pv = __shfl_xor(v, 16);
                const f32x2 cs = csA[(tok & (SEQ - 1)) * 16 + (r & 15)];
                o = (r < 16) ? (v * cs.x - pv * cs.y) : (pv * cs.y + v * cs.x);
            }
            Qa[(size_t)tok * 768 + c0 + r] = f2bf(o * QA_SCALE);
        }
    }
};
struct EpiKV {
    bf16_t *Ka, *Va; const float* rs; int row0;
    DI void operator()(const f32x16& acc, int tok0, int c0, int lane) const {
        const int r = lane & 31, h = lane >> 5;
        const int hh = c0 >> 7, w = c0 & 127;
        bf16_t* dst; int ld;
        if (w < 64) { dst = Ka + hh * 96 + w; ld = 768; } else { dst = Va + hh * 64 + (w - 64); ld = 512; }
#pragma unroll
        for (int i = 0; i < 16; ++i) { const int tok = tok0 + crow(i, h); dst[(size_t)tok * ld + r] = f2bf(acc[i] * rs[tok - row0]); }
    }
};
struct EpiOut {
    const float* x; float* out;
    DI void operator()(const f32x16& acc, int tok0, int c0, int lane) const {
        const int r = lane & 31, h = lane >> 5;
#pragma unroll
        for (int i = 0; i < 16; ++i) { const size_t o = (size_t)(tok0 + crow(i, h)) * DM + c0 + r; out[o] = DN_ALPHA * x[o] + acc[i]; }
    }
};

DI void row_rms(const bf16_t* A, int K, int row0, float* rs) {
    const int tid = threadIdx.x, row = tid >> 1, half = tid & 1;
    const int nch = K >> 4;
    const u32x4* p = (const u32x4*)(A + (size_t)(row0 + row) * K + half * (K >> 1));
    float s = 0.f;
    for (int c = 0; c < nch; ++c) {
        const u32x4 v = p[c];
#pragma unroll
        for (int j = 0; j < 4; ++j) { const float a = bf_lo(v[j]), b = bf_hi(v[j]); s += a * a + b * b; }
    }
    s += __shfl_xor(s, 1);
    if (half == 0) rs[row] = __builtin_amdgcn_rsqf(s / (float)K + 1e-6f);
    __syncthreads();
}

DI void mla_item(const Params& p, int b, int hh, int qb, char* lds) {
    const bf16_t* Qa = (const bf16_t*)(p.ws + WS_QA); const bf16_t* Ka = (const bf16_t*)(p.ws + WS_KA); const bf16_t* Va = (const bf16_t*)(p.ws + WS_VA);
    const bf16_t* gA = (const bf16_t*)(p.ws + WS_GA); bf16_t* mix = (bf16_t*)(p.ws + WS_MIX);
    const int tid = threadIdx.x, lane = tid & 63, wid = tid >> 6, r = lane & 31, h = lane >> 5;
    const size_t tokbase = (size_t)b * SEQ;
    const int q0 = qb * 128, qpos = q0 + wid * 32 + r;
    bf16x8 qf[6];
    { const bf16_t* qrow = Qa + (tokbase + qpos) * 768 + hh * 96 + 8 * h;
#pragma unroll
      for (int s = 0; s < 6; ++s) qf[s] = *(const bf16x8*)(qrow + 16 * s); }
    int kg[3], kl[3];
#pragma unroll
    for (int i = 0; i < 3; ++i) { const int c = tid + 256 * i, key = c / 12, cc = c - key * 12; kg[i] = key * 768 + cc * 8; kl[i] = (cc < 8) ? sw128(key, cc) : (8192 + sw64(key, cc - 8)); }
    int vg[2], vl[2];
#pragma unroll
    for (int i = 0; i < 2; ++i) { const int key = (tid >> 3) + 32 * i, cc = tid & 7; vg[i] = key * 512 + cc * 8; vl[i] = 12288 + swV(key, cc); }
    const bf16_t* kbase = Ka + tokbase * 768 + hh * 96;
    const bf16_t* vbase = Va + tokbase * 512 + hh * 64;
    const int tp = lane & 3, tq = (lane >> 2) & 3, tblk = (lane >> 4) & 1;
    const int vswz = ((tq >> 1) & 1) << 2;

    f32x16 o[2]; o[0] = zero16(); o[1] = zero16();
    float m = NEGBIG, l = 0.f;
    const int ntiles = 2 * qb + 2;
    u32x4 rk[3], rv[2];
#pragma unroll
    for (int i = 0; i < 3; ++i) rk[i] = *(const u32x4*)(kbase + kg[i]);
#pragma unroll
    for (int i = 0; i < 2; ++i) rv[i] = *(const u32x4*)(vbase + vg[i]);
    for (int t = 0; t < ntiles; ++t) {
        char* st = lds + (t & 1) * 20480;
#pragma unroll
        for (int i = 0; i < 3; ++i) *(u32x4*)(st + kl[i]) = rk[i];
#pragma unroll
        for (int i = 0; i < 2; ++i) *(u32x4*)(st + vl[i]) = rv[i];
        __syncthreads();
        if (t + 1 < ntiles) {
            const size_t ko = (size_t)(t + 1) * 64 * 768, vo = (size_t)(t + 1) * 64 * 512;
#pragma unroll
            for (int i = 0; i < 3; ++i) rk[i] = *(const u32x4*)(kbase + ko + kg[i]);
#pragma unroll
            for (int i = 0; i < 2; ++i) rv[i] = *(const u32x4*)(vbase + vo + vg[i]);
        }
        const int k0 = t * 64;
        if (k0 <= q0 + wid * 32 + 31) {
            f32x16 s[2];
#pragma unroll
            for (int kt = 0; kt < 2; ++kt) {
                s[kt] = zero16();
                const int kr = kt * 32 + r;
#pragma unroll
                for (int ss = 0; ss < 6; ++ss) {
                    const bf16x8 kf = (ss < 4) ? lds_r128(st + sw128(kr, 2 * ss + h)) : lds_r128(st + 8192 + sw64(kr, 2 * (ss - 4) + h));
                    s[kt] = MFMA(kf, qf[ss], s[kt]);
                }
            }
            if (k0 + 63 > q0 + wid * 32) {
#pragma unroll
                for (int kt = 0; kt < 2; ++kt)
#pragma unroll
                    for (int i = 0; i < 16; ++i) { const int key = k0 + kt * 32 + crow(i, h); if (key > qpos) s[kt][i] = NEGBIG; }
            }
            float mx = s[0][0];
#pragma unroll
            for (int kt = 0; kt < 2; ++kt)
#pragma unroll
                for (int i = 0; i < 16; ++i) mx = fmaxf(mx, s[kt][i]);
            mx = fmaxf(mx, __shfl_xor(mx, 32));
            const float mnew = fmaxf(m, mx);
            const float alpha = __builtin_amdgcn_exp2f(m - mnew);
            float ps = 0.f;
#pragma unroll
            for (int kt = 0; kt < 2; ++kt)
#pragma unroll
                for (int i = 0; i < 16; ++i) { const float e = __builtin_amdgcn_exp2f(s[kt][i] - mnew); s[kt][i] = e; ps += e; }
            ps += __shfl_xor(ps, 32);
            l = l * alpha + ps; m = mnew;
#pragma unroll
            for (int dt = 0; dt < 2; ++dt)
#pragma unroll
                for (int i = 0; i < 16; ++i) o[dt][i] *= alpha;
#pragma unroll
            for (int kt = 0; kt < 2; ++kt)
#pragma unroll
                for (int ss = 0; ss < 2; ++ss) {
                    const bf16x8 pb = pack8(s[kt], ss);
                    const int key_lo = kt * 32 + 16 * ss + 4 * h + tq;
#pragma unroll
                    for (int dt = 0; dt < 2; ++dt) {
                        const int ch = (dt * 4 + 2 * tblk + (tp >> 1)) ^ vswz;
                        const char* a0 = st + 12288 + key_lo * 128 + (ch << 4) + 8 * (tp & 1);
                        const s16x4 lo = lds_tr(a0), hi = lds_tr(a0 + 8 * 128);
                        const bf16x8 vf = __builtin_shufflevector(lo, hi, 0, 1, 2, 3, 4, 5, 6, 7);
                        o[dt] = MFMA(vf, pb, o[dt]);
                    }
                }
        }
    }
    const float inv = 1.f / l;
    const size_t tok = tokbase + qpos;
#pragma unroll
    for (int dt = 0; dt < 2; ++dt)
#pragma unroll
        for (int g = 0; g < 4; ++g) {
            const int dv = dt * 32 + 8 * g + 4 * h;
            const u32x2 gv = *(const u32x2*)(gA + tok * 512 + hh * 64 + dv);
            u32x2 w;
            w[0] = pk2(o[dt][4 * g + 0] * inv * bf_lo(gv[0]), o[dt][4 * g + 1] * inv * bf_hi(gv[0]));
            w[1] = pk2(o[dt][4 * g + 2] * inv * bf_lo(gv[1]), o[dt][4 * g + 3] * inv * bf_hi(gv[1]));
            *(u32x2*)(mix + tok * 1024 + hh * 64 + dv) = w;
        }
    __syncthreads();
}

DI void dil_item(const Params& p, int br, int b, int hh, int res, int nb, char* lds) {
    const bf16_t* Qb = (const bf16_t*)(p.ws + WS_QB); const bf16_t* Kb = (const bf16_t*)(p.ws + WS_KB); const bf16_t* Vb = (const bf16_t*)(p.ws + WS_VB);
    bf16_t* opart = (bf16_t*)(p.ws + WS_OPART); float* lse = (float*)(p.ws + WS_LSE);
    const int tid = threadIdx.x, lane = tid & 63, wid = tid >> 6, r = lane & 31, h = lane >> 5;
    const int d = (br == 0) ? 1 : ((br == 1) ? 4 : 16);
    const size_t tokbase = (size_t)b * SEQ;
    {
        const int cc = tid & 7, kkb = tid >> 3;
        u32x4 rk[8], rv[8];
#pragma unroll
        for (int i = 0; i < 8; ++i) {
            const int kk = kkb + 32 * i, km = 128 * (nb - 1) + kk;
            if (km >= 0) {
                const size_t off = (tokbase + (size_t)km * d + res) * 512 + hh * 64 + cc * 8;
                rk[i] = *(const u32x4*)(Kb + off); rv[i] = *(const u32x4*)(Vb + off);
            } else { rk[i] = (u32x4){0u, 0u, 0u, 0u}; rv[i] = (u32x4){0u, 0u, 0u, 0u}; }
        }
#pragma unroll
        for (int i = 0; i < 8; ++i) { const int kk = kkb + 32 * i; *(u32x4*)(lds + sw128(kk, cc)) = rk[i]; *(u32x4*)(lds + 32768 + swV(kk, cc)) = rv[i]; }
    }
    const int qm = 128 * nb + wid * 32 + r;
    const size_t qtok = tokbase + (size_t)qm * d + res;
    bf16x8 qf[4];
    { const bf16_t* qrow = Qb + qtok * 512 + hh * 64 + 8 * h;
#pragma unroll
      for (int s = 0; s < 4; ++s) qf[s] = *(const bf16x8*)(qrow + 16 * s); }
    __syncthreads();
    f32x16 s[5];
#pragma unroll
    for (int u = 0; u < 5; ++u) {
        const bool skip = (nb == 0) && (wid + u < 4);
        if (!skip) {
            s[u] = zero16();
            const int kr = 32 * (wid + u) + r;
#pragma unroll
            for (int ss = 0; ss < 4; ++ss) s[u] = MFMA(lds_r128(lds + sw128(kr, 2 * ss + h)), qf[ss], s[u]);
        } else {
#pragma unroll
            for (int i = 0; i < 16; ++i) s[u][i] = NEGBIG;
        }
    }
#pragma unroll
    for (int i = 0; i < 16; ++i) { const int j = crow(i, h); if (j < r) s[0][i] = NEGBIG; if (j > r) s[4][i] = NEGBIG; }
    float mx = s[0][0];
#pragma unroll
    for (int u = 0; u < 5; ++u)
#pragma unroll
        for (int i = 0; i < 16; ++i) mx = fmaxf(mx, s[u][i]);
    mx = fmaxf(mx, __shfl_xor(mx, 32));
    float l = 0.f;
#pragma unroll
    for (int u = 0; u < 5; ++u)
#pragma unroll
        for (int i = 0; i < 16; ++i) { const float e = __builtin_amdgcn_exp2f(s[u][i] - mx); s[u][i] = e; l += e; }
    l += __shfl_xor(l, 32);
    f32x16 o[2]; o[0] = zero16(); o[1] = zero16();
    const int tp = lane & 3, tq = (lane >> 2) & 3, tblk = (lane >> 4) & 1;
    const int vswz = ((tq >> 1) & 1) << 2;
#pragma unroll
    for (int u = 0; u < 5; ++u) {
        const bool skip = (nb == 0) && (wid + u < 4);
        if (!skip) {
#pragma unroll
            for (int ss = 0; ss < 2; ++ss) {
                const bf16x8 pb = pack8(s[u], ss);
                const int key_lo = 32 * (wid + u) + 16 * ss + 4 * h + tq;
#pragma unroll
                for (int dt = 0; dt < 2; ++dt) {
                    const int ch = (dt * 4 + 2 * tblk + (tp >> 1)) ^ vswz;
                    const char* a0 = lds + 32768 + key_lo * 128 + (ch << 4) + 8 * (tp & 1);
                    const s16x4 lo = lds_tr(a0), hi = lds_tr(a0 + 8 * 128);
                    const bf16x8 vf = __builtin_shufflevector(lo, hi, 0, 1, 2, 3, 4, 5, 6, 7);
                    o[dt] = MFMA(vf, pb, o[dt]);
                }
            }
        }
    }
    const float inv = 1.f / l;
    bf16_t* op = opart + ((size_t)br * T + qtok) * 512 + hh * 64;
#pragma unroll
    for (int dt = 0; dt < 2; ++dt)
#pragma unroll
        for (int g = 0; g < 4; ++g) {
            const int dv = dt * 32 + 8 * g + 4 * h;
            u32x2 w;
            w[0] = pk2(o[dt][4 * g + 0] * inv, o[dt][4 * g + 1] * inv);
            w[1] = pk2(o[dt][4 * g + 2] * inv, o[dt][4 * g + 3] * inv);
            *(u32x2*)(op + dv) = w;
        }
    if (h == 0) lse[((size_t)br * T + qtok) * 8 + hh] = mx + __builtin_amdgcn_logf(l);
    __syncthreads();
}


#define XB_TMO      128
#define XB_XCNT(j)  (256  + 64 * (j))
#define XB_XSUB(j)  (1280 + 64 * (j))
#define XB_XGEN(j)  (2304 + 64 * (j))
#define XB_TOP      3328
#define XB_TOPGEN   3392
#define XCD_BAR_WORDS 3456
#define XB_SPIN_CAP (1u << 18)
DI unsigned xb_ld(unsigned* p)              { return __hip_atomic_load(p, __ATOMIC_RELAXED, __HIP_MEMORY_SCOPE_AGENT); }
DI unsigned xb_add(unsigned* p, unsigned v) { return __hip_atomic_fetch_add(p, v, __ATOMIC_RELAXED, __HIP_MEMORY_SCOPE_AGENT); }
DI unsigned xb_xcc_id() { return (unsigned)__builtin_amdgcn_s_getreg((3 << 11) | 20) & 0xFu; }
#define XB_SPIN(cond, bar) do { unsigned _sp = 0; while (cond) { __builtin_amdgcn_s_sleep(1); \
    if ((++_sp & 255u) == 0u) { if (xb_ld(&(bar)[XB_TMO])) break; if (_sp > XB_SPIN_CAP) { atomicAdd(&(bar)[XB_TMO], 1u); break; } } } } while (0)
struct XcdBarrier { unsigned* bar; unsigned x; volatile LAS unsigned* st; };
DI XcdBarrier xcd_barrier_post(unsigned* bar, volatile LAS unsigned* st) {
    XcdBarrier b; b.bar = bar; b.x = xb_xcc_id(); b.st = st;
    if (threadIdx.x == 0) (void)xb_add(&bar[XB_XCNT(b.x)], 1u);
    return b;
}
DI void xcd_barrier_complete(unsigned* bar, unsigned x, unsigned& nloc, unsigned& nx) {
    const unsigned G = gridDim.x * gridDim.y * gridDim.z;
    unsigned sum, cnt, mine, sp = 0u;
    for (;;) {
        sum = 0u; cnt = 0u; mine = 0u;
#pragma unroll
        for (unsigned j = 0; j < 16; ++j) { const unsigned c = xb_ld(&bar[XB_XCNT(j)]); sum += c; cnt += (c > 0u) ? 1u : 0u; mine = (j == x) ? c : mine; }
        if (sum == G) break;
        __builtin_amdgcn_s_sleep(1);
        if ((++sp & 255u) == 0u) { if (xb_ld(&bar[XB_TMO])) break; if (sp > XB_SPIN_CAP) { atomicAdd(&bar[XB_TMO], 1u); break; } }
    }
    nloc = mine > 0u ? mine : 1u; nx = cnt > 0u ? cnt : 1u;
}
DI void xcd_barrier(const XcdBarrier& b) {
    asm volatile("s_waitcnt vmcnt(0)" ::: "memory");
    __syncthreads();
    if (threadIdx.x == 0) {
        unsigned* bar = b.bar;
        __builtin_amdgcn_s_waitcnt(0);
        unsigned nloc = b.st[0], nx = b.st[1];
        if (nloc == 0u) { xcd_barrier_complete(bar, b.x, nloc, nx); b.st[0] = nloc; b.st[1] = nx; }
        const unsigned old = xb_add(&bar[XB_XSUB(b.x)], 1u);
        const unsigned gen = old / nloc;
        if (old + 1u == (gen + 1u) * nloc) {
            __builtin_amdgcn_fence(__ATOMIC_RELEASE, "agent");
            asm volatile("s_waitcnt vmcnt(0)" ::: "memory");
            const unsigned og = xb_add(&bar[XB_TOP], 1u);
            const unsigned tg = og / nx;
            if (og + 1u == (tg + 1u) * nx) xb_add(&bar[XB_TOPGEN], 1u);
            else XB_SPIN(xb_ld(&bar[XB_TOPGEN]) == tg, bar);
            __builtin_amdgcn_fence(__ATOMIC_ACQUIRE, "agent");
            xb_add(&bar[XB_XGEN(b.x)], 1u);
            asm volatile("s_waitcnt vmcnt(0)" ::: "memory");
        } else {
            XB_SPIN(xb_ld(&bar[XB_XGEN(b.x)]) == gen, bar);
            __builtin_amdgcn_fence(__ATOMIC_ACQUIRE, "agent");
            asm volatile("s_waitcnt vmcnt(0)" ::: "memory");
        }
    }
    __syncthreads();
}

DI void phase0(const Params& p) {
    const size_t gtid = (size_t)blockIdx.x * NTHREADS + threadIdx.x, gsz = (size_t)gridDim.x * NTHREADS;
    { u32x4* xb = (u32x4*)(p.ws + WS_XB); const f32x4* x4 = (const f32x4*)p.x;
      for (size_t i = gtid; i < (size_t)T * 1024 / 8; i += gsz) { const f32x4 a = x4[2 * i], b = x4[2 * i + 1]; u32x4 w; w[0] = pk2(a[0], a[1]); w[1] = pk2(a[2], a[3]); w[2] = pk2(b[0], b[1]); w[3] = pk2(b[2], b[3]); xb[i] = w; } }
    { bf16_t* wt = (bf16_t*)(p.ws + WS_WINT);
      for (size_t i = gtid; i < (size_t)INWP * 128; i += gsz) { const int n = (int)(i % INWP), k8 = (int)(i / INWP); float v[8];
#pragma unroll
        for (int j = 0; j < 8; ++j) v[j] = (n < INW) ? p.w_in[(size_t)(k8 * 8 + j) * INW + n] : 0.f;
        u32x4 w; w[0] = pk2(v[0], v[1]); w[1] = pk2(v[2], v[3]); w[2] = pk2(v[4], v[5]); w[3] = pk2(v[6], v[7]); *(u32x4*)(wt + (size_t)n * 1024 + k8 * 8) = w; } }
    { bf16_t* wt = (bf16_t*)(p.ws + WS_WUQT);
      for (size_t i = gtid; i < (size_t)768 * 48; i += gsz) { const int n = (int)(i % 768), k8 = (int)(i / 768); float v[8];
#pragma unroll
        for (int j = 0; j < 8; ++j) v[j] = p.w_uq[(size_t)(k8 * 8 + j) * 768 + n] * p.qg[k8 * 8 + j];
        u32x4 w; w[0] = pk2(v[0], v[1]); w[1] = pk2(v[2], v[3]); w[2] = pk2(v[4], v[5]); w[3] = pk2(v[6], v[7]); *(u32x4*)(wt + (size_t)n * 384 + k8 * 8) = w; } }
    { bf16_t* wt = (bf16_t*)(p.ws + WS_WUKVT);
      for (size_t i = gtid; i < (size_t)1024 * 32; i += gsz) { const int n = (int)(i % 1024), k8 = (int)(i / 1024); float v[8];
#pragma unroll
        for (int j = 0; j < 8; ++j) v[j] = p.w_ukv[(size_t)(k8 * 8 + j) * 1024 + n] * p.kvg[k8 * 8 + j];
        u32x4 w; w[0] = pk2(v[0], v[1]); w[1] = pk2(v[2], v[3]); w[2] = pk2(v[4], v[5]); w[3] = pk2(v[6], v[7]); *(u32x4*)(wt + (size_t)n * 256 + k8 * 8) = w; } }
    { bf16_t* wt = (bf16_t*)(p.ws + WS_WOUTT);
      for (size_t i = gtid; i < (size_t)1024 * 128; i += gsz) { const int n = (int)(i % 1024), k8 = (int)(i / 1024); float v[8];
#pragma unroll
        for (int j = 0; j < 8; ++j) v[j] = p.w_out[(size_t)(k8 * 8 + j) * 1024 + n];
        u32x4 w; w[0] = pk2(v[0], v[1]); w[1] = pk2(v[2], v[3]); w[2] = pk2(v[4], v[5]); w[3] = pk2(v[6], v[7]); *(u32x4*)(wt + (size_t)n * 1024 + k8 * 8) = w; } }
    { f32x2* csA = (f32x2*)(p.ws + WS_CSA); f32x2* csB = (f32x2*)(p.ws + WS_CSB);
      for (size_t i = gtid; i < (size_t)SEQ * 24; i += gsz) {
          int pos, f, dim; f32x2* dst;
          if (i < (size_t)SEQ * 16) { pos = (int)(i >> 4); f = (int)(i & 15); dim = 32; dst = csA + i; } else { const size_t j = i - (size_t)SEQ * 16; pos = (int)(j >> 3); f = (int)(j & 7); dim = 16; dst = csB + j; }
          const float invf = __builtin_exp2f(-(float)(2 * f) / (float)dim * 18.931568569324174f);
          const float ang = (float)pos * invf;
          const double rev = (double)ang * 0.15915494309189535;
          const float fr = (float)(rev - __builtin_rint(rev));
          *dst = (f32x2){__builtin_amdgcn_cosf(fr), __builtin_amdgcn_sinf(fr)};
      } }
}

DI int vblock() { const int per = gridDim.x >> 3; return (blockIdx.x & 7) * per + (blockIdx.x >> 3); }

DI void phase1(const Params& p, char* lds) {
    Epi1 e; e.cq = (bf16_t*)(p.ws + WS_CQ); e.ckv = (bf16_t*)(p.ws + WS_CKV); e.Ka = (bf16_t*)(p.ws + WS_KA); e.gA = (bf16_t*)(p.ws + WS_GA);
    e.Qb = (bf16_t*)(p.ws + WS_QB); e.Kb = (bf16_t*)(p.ws + WS_KB); e.Vb = (bf16_t*)(p.ws + WS_VB); e.gB = (bf16_t*)(p.ws + WS_GB);
    e.csA = (const f32x2*)(p.ws + WS_CSA); e.csB = (const f32x2*)(p.ws + WS_CSB);
    const bf16_t* xb = (const bf16_t*)(p.ws + WS_XB); const bf16_t* wt = (const bf16_t*)(p.ws + WS_WINT);
    constexpr int NC = INWP / 128, NT = (T / 128) * NC;
    for (int t = vblock(); t < NT; t += gridDim.x) { const int rt = t / NC, ct = t - rt * NC; gemm_tile(xb, 1024, wt, 1024, 1024, rt * 128, ct * 128, lds, e); }
}

DI void phase2(const Params& p, char* lds) {
    float* rs = (float*)(lds + LDS_TAIL);
    const bf16_t* cq = (const bf16_t*)(p.ws + WS_CQ); const bf16_t* ckv = (const bf16_t*)(p.ws + WS_CKV);
    constexpr int NQ = 128 * 6, NKV = 128 * 8;
    for (int t = vblock(); t < NQ + NKV; t += gridDim.x) {
        if (t < NQ) {
            const int rt = t / 6, ct = t - rt * 6;
            row_rms(cq, 384, rt * 128, rs);
            EpiQ e; e.Qa = (bf16_t*)(p.ws + WS_QA); e.csA = (const f32x2*)(p.ws + WS_CSA); e.rs = rs; e.row0 = rt * 128;
            gemm_tile(cq, 384, (const bf16_t*)(p.ws + WS_WUQT), 384, 384, rt * 128, ct * 128, lds, e);
        } else {
            const int u = t - NQ, rt = u >> 3, ct = u & 7;
            row_rms(ckv, 256, rt * 128, rs);
            EpiKV e; e.Ka = (bf16_t*)(p.ws + WS_KA); e.Va = (bf16_t*)(p.ws + WS_VA); e.rs = rs; e.row0 = rt * 128;
            gemm_tile(ckv, 256, (const bf16_t*)(p.ws + WS_WUKVT), 256, 256, rt * 128, ct * 128, lds, e);
        }
    }
}

DI void phase3(const Params& p, char* lds, int which = 0) {
    unsigned* ctr = (unsigned*)(p.ws + WS_CTR) + which;
    int* slot = (int*)(lds + LDS_TAIL + 512);
    for (;;) {
        __syncthreads();
        if (threadIdx.x == 0) *slot = (int)atomicAdd(ctr, 1u);
        __syncthreads();
        const int it = *slot;
        if (it >= 4096) break;
        if (it < 1024) {
            const int qb = 31 - (it >> 5), bh = it & 31;
            mla_item(p, bh >> 3, bh & 7, qb, lds);
        } else {
            const int j = it - 1024, br = j >> 10, rem = j & 1023, bh = rem >> 5, w = rem & 31;
            const int nblk = (br == 0) ? 32 : ((br == 1) ? 8 : 2);
            const int res = w / nblk, nb = w - res * nblk;
            dil_item(p, br, bh >> 3, bh & 7, res, nb, lds);
        }
    }
}

DI void phase4(const Params& p) {
    const bf16_t* opart = (const bf16_t*)(p.ws + WS_OPART); const float* lse = (const float*)(p.ws + WS_LSE); const bf16_t* gB = (const bf16_t*)(p.ws + WS_GB);
    bf16_t* mix = (bf16_t*)(p.ws + WS_MIX);
    const size_t gtid = (size_t)blockIdx.x * NTHREADS + threadIdx.x, gsz = (size_t)gridDim.x * NTHREADS;
    for (size_t i = gtid; i < (size_t)T * 64; i += gsz) {
        const size_t tok = i >> 6; const int c8 = (int)(i & 63), hh = c8 >> 3;
        const float l0 = lse[tok * 8 + hh], l1 = lse[((size_t)T + tok) * 8 + hh], l2 = lse[((size_t)2 * T + tok) * 8 + hh];
        const float M = fmaxf(l0, fmaxf(l1, l2));
        float w0 = __builtin_amdgcn_exp2f(l0 - M), w1 = __builtin_amdgcn_exp2f(l1 - M), w2 = __builtin_amdgcn_exp2f(l2 - M);
        const float inv = 1.f / (w0 + w1 + w2); w0 *= inv; w1 *= inv; w2 *= inv;
        const u32x4 a = *(const u32x4*)(opart + tok * 512 + c8 * 8), b = *(const u32x4*)(opart + ((size_t)T + tok) * 512 + c8 * 8), c = *(const u32x4*)(opart + ((size_t)2 * T + tok) * 512 + c8 * 8);
        const u32x4 g = *(const u32x4*)(gB + tok * 512 + c8 * 8);
        u32x4 o;
#pragma unroll
        for (int j = 0; j < 4; ++j) {
            const float lo = (w0 * bf_lo(a[j]) + w1 * bf_lo(b[j]) + w2 * bf_lo(c[j])) * bf_lo(g[j]);
            const float hi = (w0 * bf_hi(a[j]) + w1 * bf_hi(b[j]) + w2 * bf_hi(c[j])) * bf_hi(g[j]);
            o[j] = pk2(lo, hi);
        }
        *(u32x4*)(mix + tok * 1024 + 512 + c8 * 8) = o;
    }
}

DI void phase5(const Params& p, char* lds) {
    EpiOut e; e.x = p.x; e.out = p.out;
    const bf16_t* mix = (const bf16_t*)(p.ws + WS_MIX); const bf16_t* wt = (const bf16_t*)(p.ws + WS_WOUTT);
    constexpr int NT = (T / 128) * 8;
    for (int t = vblock(); t < NT; t += gridDim.x) { const int rt = t >> 3, ct = t & 7; gemm_tile(mix, 1024, wt, 1024, 1024, rt * 128, ct * 128, lds, e); }
}

DI void phase6(const Params& p) {
    const int lane = threadIdx.x & 63, wid = threadIdx.x >> 6;
    const int gw = blockIdx.x * 4 + wid, nw = gridDim.x * 4;
    f32x4 g[4], bb[4];
#pragma unroll
    for (int j = 0; j < 4; ++j) { g[j] = *(const f32x4*)(p.ln_g + lane * 4 + 256 * j); bb[j] = *(const f32x4*)(p.ln_b + lane * 4 + 256 * j); }
    for (int row = gw; row < T; row += nw) {
        float* rp = p.out + (size_t)row * DM + lane * 4;
        f32x4 v[4]; float s = 0.f;
#pragma unroll
        for (int j = 0; j < 4; ++j) { v[j] = *(const f32x4*)(rp + 256 * j); s += (v[j][0] + v[j][1]) + (v[j][2] + v[j][3]); }
#pragma unroll
        for (int o = 32; o > 0; o >>= 1) s += __shfl_xor(s, o);
        const float mu = s * (1.f / 1024.f); float q = 0.f;
#pragma unroll
        for (int j = 0; j < 4; ++j) { v[j] = v[j] - mu; q += (v[j][0] * v[j][0] + v[j][1] * v[j][1]) + (v[j][2] * v[j][2] + v[j][3] * v[j][3]); }
#pragma unroll
        for (int o = 32; o > 0; o >>= 1) q += __shfl_xor(q, o);
        const float rstd = __builtin_amdgcn_rsqf(q * (1.f / 1024.f) + 1e-5f);
#pragma unroll
        for (int j = 0; j < 4; ++j) *(f32x4*)(rp + 256 * j) = v[j] * rstd * g[j] + bb[j];
    }
}

template <int LO, int HI>
__global__ void __launch_bounds__(NTHREADS, 2) fwd_megakernel(Params p) {
    extern __shared__ __attribute__((aligned(16))) char lds[];
    volatile LAS unsigned* xst = (volatile LAS unsigned*)(LAS char*)(lds + LDS_TAIL + 768);
    XcdBarrier gb; gb.bar = (unsigned*)(p.ws + WS_BAR); gb.x = 0; gb.st = xst;
    if constexpr (HI - LO > 1) {
        if (threadIdx.x == 0) { xst[0] = 0u; xst[1] = 0u; xst[2] = 0u; xst[3] = 0u; }
        __syncthreads();
        gb = xcd_barrier_post((unsigned*)(p.ws + WS_BAR), xst);
    }
#define GSYNC() xcd_barrier(gb)
    if constexpr (LO <= 0 && 0 < HI) { phase0(p); if constexpr (1 < HI) GSYNC(); }
    if constexpr (LO <= 1 && 1 < HI) { phase1(p, lds); if (PROBE_DUP == 1) { GSYNC(); phase1(p, lds); } if constexpr (2 < HI) GSYNC(); }
    if constexpr (LO <= 2 && 2 < HI) { phase2(p, lds); if (PROBE_DUP == 2) { GSYNC(); phase2(p, lds); } if constexpr (3 < HI) GSYNC(); }
    if constexpr (LO <= 3 && 3 < HI) { phase3(p, lds); if (PROBE_DUP == 3) { GSYNC(); phase3(p, lds, 1); } if constexpr (4 < HI) GSYNC(); }
    if constexpr (LO <= 4 && 4 < HI) { phase4(p); if constexpr (5 < HI) GSYNC(); }
    if constexpr (LO <= 5 && 5 < HI) { phase5(p, lds); if (PROBE_DUP == 5) { GSYNC(); phase5(p, lds); } if constexpr (6 < HI) GSYNC(); }
    if (PROBE_DUP == 7) { for (int i = 0; i < 10; ++i) GSYNC(); }
    if constexpr (LO <= 6 && 6 < HI) { phase6(p); }
}

#ifndef N_LAUNCH
#define N_LAUNCH 1
#endif

extern "C" void kernel_launch(void* const* d_in, const int* in_sizes, int n_in, void* d_out, int out_size, void* d_ws, size_t ws_size, hipStream_t stream) {
    static int grid_blocks = 0;
    if (grid_blocks == 0) {
        if (n_in != 9 || ws_size < WS_END) { fprintf(stderr, "kernel_launch: unexpected n_in %d / ws %zu (need %zu)\n", n_in, ws_size, (size_t)WS_END); grid_blocks = -1; return; }
        int dev = 0, cus = 0, per_cu = 0;
        (void)hipGetDevice(&dev);
        (void)hipDeviceGetAttribute(&cus, hipDeviceAttributeMultiprocessorCount, dev);
#if N_LAUNCH == 1
        if (hipFuncSetAttribute((const void*)fwd_megakernel<0, 7>, hipFuncAttributeMaxDynamicSharedMemorySize, LDS_BYTES) != hipSuccess) { fprintf(stderr, "kernel_launch: hipFuncSetAttribute failed\n"); grid_blocks = -1; return; }
#else
        (void)hipFuncSetAttribute((const void*)fwd_megakernel<0, 1>, hipFuncAttributeMaxDynamicSharedMemorySize, LDS_BYTES);
        (void)hipFuncSetAttribute((const void*)fwd_megakernel<1, 2>, hipFuncAttributeMaxDynamicSharedMemorySize, LDS_BYTES);
        (void)hipFuncSetAttribute((const void*)fwd_megakernel<2, 3>, hipFuncAttributeMaxDynamicSharedMemorySize, LDS_BYTES);
        (void)hipFuncSetAttribute((const void*)fwd_megakernel<3, 4>, hipFuncAttributeMaxDynamicSharedMemorySize, LDS_BYTES);
        (void)hipFuncSetAttribute((const void*)fwd_megakernel<4, 5>, hipFuncAttributeMaxDynamicSharedMemorySize, LDS_BYTES);
        (void)hipFuncSetAttribute((const void*)fwd_megakernel<5, 6>, hipFuncAttributeMaxDynamicSharedMemorySize, LDS_BYTES);
        (void)hipFuncSetAttribute((const void*)fwd_megakernel<6, 7>, hipFuncAttributeMaxDynamicSharedMemorySize, LDS_BYTES);
#endif
        if (hipOccupancyMaxActiveBlocksPerMultiprocessor(&per_cu, (const void*)fwd_megakernel<0, 7>, NTHREADS, LDS_BYTES) != hipSuccess || per_cu < 1) { fprintf(stderr, "kernel_launch: occupancy query failed (%d)\n", per_cu); grid_blocks = -1; return; }
        if (per_cu > 2) per_cu = 2;
        grid_blocks = cus * per_cu;
        grid_blocks -= grid_blocks % 8;
        fprintf(stderr, "kernel_launch: cus %d per_cu %d grid %d\n", cus, per_cu, grid_blocks);
    }
    if (grid_blocks <= 0) return;
    (void)hipMemsetAsync((char*)d_ws + WS_BAR, 0, CTL_BYTES, stream);
    Params p{};
    p.x = (const float*)d_in[0]; p.w_in = (const float*)d_in[1]; p.qg = (const float*)d_in[2]; p.kvg = (const float*)d_in[3]; p.w_uq = (const float*)d_in[4];
    p.w_ukv = (const float*)d_in[5]; p.w_out = (const float*)d_in[6]; p.ln_g = (const float*)d_in[7]; p.ln_b = (const float*)d_in[8];
    p.out = (float*)d_out; p.ws = (unsigned char*)d_ws;
#if N_LAUNCH == 1
    hipLaunchKernelGGL((fwd_megakernel<0, 7>), dim3(grid_blocks), dim3(NTHREADS), LDS_BYTES, stream, p);
#else
    hipLaunchKernelGGL((fwd_megakernel<0, 1>), dim3(grid_blocks), dim3(NTHREADS), LDS_BYTES, stream, p);
    hipLaunchKernelGGL((fwd_megakernel<1, 2>), dim3(grid_blocks), dim3(NTHREADS), LDS_BYTES, stream, p);
    hipLaunchKernelGGL((fwd_megakernel<2, 3>), dim3(grid_blocks), dim3(NTHREADS), LDS_BYTES, stream, p);
    hipLaunchKernelGGL((fwd_megakernel<3, 4>), dim3(grid_blocks), dim3(NTHREADS), LDS_BYTES, stream, p);
    hipLaunchKernelGGL((fwd_megakernel<4, 5>), dim3(grid_blocks), dim3(NTHREADS), LDS_BYTES, stream, p);
    hipLaunchKernelGGL((fwd_megakernel<5, 6>), dim3(grid_blocks), dim3(NTHREADS), LDS_BYTES, stream, p);
    hipLaunchKernelGGL((fwd_megakernel<6, 7>), dim3(grid_blocks), dim3(NTHREADS), LDS_BYTES, stream, p);
#endif
}
```

```cpp
#include <hip/hip_runtime.h>
#include <cstdio>

#define DI __device__ __forceinline__
#ifndef PROBE_DUP
#define PROBE_DUP 0
#endif
#define LAS __attribute__((address_space(3)))
typedef unsigned short bf16_t;
typedef short bf16x8 __attribute__((ext_vector_type(8)));
typedef short s16x4 __attribute__((ext_vector_type(4)));
typedef float f32x16 __attribute__((ext_vector_type(16)));
typedef float f32x4 __attribute__((ext_vector_type(4)));
typedef float f32x2 __attribute__((ext_vector_type(2)));
typedef unsigned u32x4 __attribute__((ext_vector_type(4)));
typedef unsigned u32x2 __attribute__((ext_vector_type(2)));
typedef __bf16 bf2_t __attribute__((ext_vector_type(2)));

constexpr int T = 16384, SEQ = 4096, DM = 1024, INW = 3232, INWP = 3328;
constexpr int NTHREADS = 512;
constexpr int RING_BYTES = 131072;
constexpr int LDS_TAIL = RING_BYTES;
constexpr int LDS_BYTES = RING_BYTES + 2048;
constexpr float LOG2E = 1.4426950408889634f;
constexpr float QA_SCALE = 0.10206207261596575f * 1.4426950408889634f;
constexpr float QB_SCALE = 0.125f * 1.4426950408889634f;
constexpr float DN_ALPHA = 1.189207115002721f;
constexpr float NEGBIG = -1e30f;

constexpr size_t SZ_XB = (size_t)T * 1024 * 2, SZ_CQ = (size_t)T * 384 * 2, SZ_CKV = (size_t)T * 256 * 2;
constexpr size_t WS_XB = 0;
constexpr size_t WS_CQ = WS_XB + SZ_XB;
constexpr size_t WS_CKV = WS_CQ + SZ_CQ;
constexpr size_t WS_OPART = 0;
constexpr size_t WS_WINT = WS_CKV + SZ_CKV;
constexpr size_t WS_WUQT = WS_WINT + (size_t)INWP * 1024 * 2;
constexpr size_t WS_WUKVT = WS_WUQT + (size_t)768 * 384 * 2;
constexpr size_t WS_WOUTT = WS_WUKVT + (size_t)1024 * 256 * 2;
constexpr size_t WS_CSA = WS_WOUTT + (size_t)1024 * 1024 * 2;
constexpr size_t WS_CSB = WS_CSA + (size_t)4096 * 16 * 8;
constexpr size_t WS_QA = WS_CSB + (size_t)4096 * 8 * 8;
constexpr size_t WS_KA = WS_QA + (size_t)T * 768 * 2;
constexpr size_t WS_VA = WS_KA + (size_t)T * 768 * 2;
constexpr size_t WS_GA = WS_VA + (size_t)T * 512 * 2;
constexpr size_t WS_GB = WS_GA + (size_t)T * 512 * 2;
constexpr size_t WS_QB = WS_GB + (size_t)T * 512 * 2;
constexpr size_t WS_KB = WS_QB + (size_t)T * 512 * 2;
constexpr size_t WS_VB = WS_KB + (size_t)T * 512 * 2;
constexpr size_t WS_MIX = WS_VB + (size_t)T * 512 * 2;
constexpr size_t WS_LSE = WS_MIX + (size_t)T * 1024 * 2;
constexpr size_t WS_BAR = WS_LSE + (size_t)3 * T * 8 * 4;
constexpr size_t WS_CTR = WS_BAR + 3456 * 4;
constexpr size_t CTL_BYTES = 3456 * 4 + 256;
constexpr size_t WS_END = WS_CTR + 256;

struct Params {
    const float* x; const float* w_in; const float* qg; const float* kvg; const float* w_uq; const float* w_ukv; const float* w_out; const float* ln_g; const float* ln_b;
    float* out; unsigned char* ws;
};

DI int tid_l() { int t = threadIdx.x; asm volatile("" : "+v"(t)); return t; }
DI int crow(int i, int h) { return (i & 3) + 8 * (i >> 2) + 4 * h; }
DI unsigned pk2(float lo, float hi) { bf2_t v = {(__bf16)lo, (__bf16)hi}; return __builtin_bit_cast(unsigned, v); }
DI float bf_lo(unsigned u) { return __uint_as_float(u << 16); }
DI float bf_hi(unsigned u) { return __uint_as_float(u & 0xffff0000u); }
DI float silu(float x) { return x * __builtin_amdgcn_rcpf(1.f + __builtin_amdgcn_exp2f(-x * LOG2E)); }
DI f32x16 zero16() { f32x16 z; for (int i = 0; i < 16; ++i) z[i] = 0.f; return z; }
#define MFMA(a, b, c) __builtin_amdgcn_mfma_f32_32x32x16_bf16((a), (b), (c), 0, 0, 0)

DI int sw128(int r, int c) { return r * 128 + ((c ^ ((r >> 1) & 7)) << 4); }
DI int sw64(int r, int c) { return r * 64 + ((c ^ ((r >> 2) & 3)) << 4); }
DI int swV(int r, int c) { return r * 128 + ((c ^ (((r >> 1) & 1) << 2)) << 4); }
DI bf16x8 lds_r128(const char* p) { return *(const bf16x8*)p; }
DI s16x4 lds_tr(const char* p) { return __builtin_amdgcn_ds_read_tr16_b64_v4i16((LAS s16x4*)(p)); }
DI bf16x8 pack8(const f32x16& x, int s) {
    u32x4 p;
    p[0] = pk2(x[8 * s + 0], x[8 * s + 1]); p[1] = pk2(x[8 * s + 2], x[8 * s + 3]);
    p[2] = pk2(x[8 * s + 4], x[8 * s + 5]); p[3] = pk2(x[8 * s + 6], x[8 * s + 7]);
    return __builtin_bit_cast(bf16x8, p);
}

namespace pg8 {
#define PG8_LAS __attribute__((address_space(3)))
typedef unsigned short bf16_t;
typedef short bf16x8 __attribute__((ext_vector_type(8)));
typedef float f32x4 __attribute__((ext_vector_type(4)));
typedef unsigned u32x4 __attribute__((ext_vector_type(4)));
constexpr int BM = 256, BK = 64, HALF = 128, HTB = HALF * BK * 2  , STAGE_BYTES = 8 * HTB, NXCD = 8, WGM = 8;

__host__ __device__ __forceinline__ int lds_byte(int r, int c) { const int st = (r >> 4) * 2 + (c >> 5), rr = r & 15, cc = c & 31, ob = rr * 64 + cc * 2; return st * 1024 + (ob ^ (((ob >> 9) & 1) << 5)); }
__host__ __device__ __forceinline__ void stage_rc(int b, int& R, int& C) { const int st = b / 1024, sb = b % 1024, swz = sb ^ (((sb >> 9) & 1) << 5); R = (st >> 1) * 16 + swz / 64; C = (st & 1) * 32 + (swz % 64) / 2; }
__host__ __device__ __forceinline__ int perm32(int rho) { const int n = rho >> 4, i = rho & 15; return 8 * (i >> 2) + 4 * n + (i & 3); }

struct Unit { int pm, pn; };
struct Gemm { const bf16_t* A; const bf16_t* Bt; int M, N, K; };

struct StaticOrder {
    int nM, nN, nwg, G, c;
    __host__ __device__ void init(int M, int N, int G_, int c_) { nM = M / BM; nN = N / BM; nwg = nM * nN; G = G_; c = c_; }
    __host__ __device__ bool next(int i, Unit& u) const {
        const long L = (long)i * G + c; if (L >= nwg) return false;
        int wgid = (int)L; { const int q = nwg / NXCD, r = nwg % NXCD, xcd = wgid % NXCD, off = wgid / NXCD; wgid = (xcd < r ? xcd * (q + 1) : r * (q + 1) + (xcd - r) * q) + off; }
        const int nig = WGM * nN, gid = wgid / nig, fm = gid * WGM, gsz = (nM - fm) < WGM ? (nM - fm) : WGM;
        u.pm = fm + ((wgid % nig) % gsz); u.pn = (wgid % nig) / gsz; return true;
    }
    __device__ __forceinline__ void a_ready(const Unit&) const {}
    __device__ __forceinline__ void done(const Unit&) const {}
};
template <class Epi, class Sched, bool ALIGN_EPI = false, bool SP2 = false>
__device__ __forceinline__ void gemm_phase(PG8_LAS unsigned char* lds, const Gemm g, const Sched& S, const Epi& E) {
    const int tid = tid_l(), wid = __builtin_amdgcn_readfirstlane(tid >> 6), lane = tid & 63, wr = wid >> 2, wc = wid & 3, fr = lane & 15, fq = lane >> 4;
    const int K = g.K, nt = K / BK;
    unsigned voffA[2], voffB[2];
#pragma unroll
    for (int i = 0; i < 2; ++i) { int R, C; stage_rc(tid * 16 + i * 8192, R, C); const int Rb = Epi::PERM ? ((R & ~31) + perm32(R & 31)) : R;
        voffA[i] = (unsigned)(R * K + C) * 2u; voffB[i] = (unsigned)(Rb * K + C) * 2u; }
    const size_t kstep = (size_t)(BK * 2);
    const size_t hstep = (size_t)HALF * K * 2;
    const size_t tstep = 2 * hstep;
    const unsigned ldsw = (unsigned)wid * 1024u;
    const int aoff = lds_byte(wr * 64 + fr, fq * 8), boff = lds_byte(wc * 32 + fr, fq * 8);
#define PG8_SA(b, h) (((b) * 2 + (h)) * HTB)
#define PG8_SB(b, h) ((4 + (b) * 2 + (h)) * HTB)
#define PG8_STAGE(bufoff, gbase, voff) do { _Pragma("unroll") for (int _i = 0; _i < 2; ++_i) \
        __builtin_amdgcn_global_load_lds((const unsigned*)((const char*)(gbase) + (voff)[_i]), (PG8_LAS unsigned*)(lds + (bufoff) + ldsw + _i * 8192), 16, 0, 0); } while (0)
#define PG8_LDA(dst, b, h) do { _Pragma("unroll") for (int m = 0; m < 4; ++m) _Pragma("unroll") for (int k = 0; k < 2; ++k) dst[m][k] = *(const PG8_LAS bf16x8*)(lds + PG8_SA(b, h) + aoff + m * 2048 + k * 1024); } while (0)
#define PG8_LDB(dst, b, h) do { _Pragma("unroll") for (int n = 0; n < 2; ++n) _Pragma("unroll") for (int k = 0; k < 2; ++k) dst[n][k] = *(const PG8_LAS bf16x8*)(lds + PG8_SB(b, h) + boff + n * 2048 + k * 1024); } while (0)
#define PG8_MMA(ai, bj, At, Bt) do { __builtin_amdgcn_s_setprio(1); _Pragma("unroll") for (int m = 0; m < 4; ++m) _Pragma("unroll") for (int n = 0; n < 2; ++n) _Pragma("unroll") for (int k = 0; k < 2; ++k) \
        acc[ai][bj][m][n] = __builtin_amdgcn_mfma_f32_16x16x32_bf16(Bt[n][k], At[m][k], acc[ai][bj][m][n], 0, 0, 0); __builtin_amdgcn_s_setprio(0); } while (0)
#define PG8_WAIT_V(n) asm volatile("s_waitcnt vmcnt(" #n ")" ::: "memory")
#define PG8_WAIT_L(n) asm volatile("s_waitcnt lgkmcnt(" #n ")" ::: "memory")
#define PG8_BAR __builtin_amdgcn_s_barrier()
#define PG8_SCHED __builtin_amdgcn_sched_barrier(0)
    Unit cur, nxt; int ui = 0;
    if (!S.next(0, cur)) return;
    f32x4 acc[2][2][4][2];
#pragma unroll
    for (int a = 0; a < 2; ++a)
#pragma unroll
        for (int b = 0; b < 2; ++b)
#pragma unroll
            for (int m = 0; m < 4; ++m)
#pragma unroll
                for (int n = 0; n < 2; ++n) acc[a][b][m][n] = (f32x4){0.f, 0.f, 0.f, 0.f};
    bf16x8 At[4][2], B0[2][2], B1[2][2];
    const char* cA = (const char*)g.A + (size_t)cur.pm * tstep; const char* cB = (const char*)g.Bt + (size_t)cur.pn * tstep;
    S.a_ready(cur);
    if constexpr (SP2) {
        PG8_STAGE(PG8_SB(0, 0), cB, voffB); PG8_STAGE(PG8_SB(0, 1), cB + hstep, voffB); PG8_STAGE(PG8_SA(0, 0), cA, voffA); PG8_STAGE(PG8_SA(0, 1), cA + hstep, voffA);
        if (wr == 1) PG8_BAR;
        PG8_WAIT_V(2); PG8_BAR;
        PG8_STAGE(PG8_SB(1, 0), cB + kstep, voffB); PG8_STAGE(PG8_SA(1, 0), cA + kstep, voffA); PG8_STAGE(PG8_SB(1, 1), cB + hstep + kstep, voffB);
        PG8_WAIT_V(6); PG8_BAR;
    } else {
        PG8_STAGE(PG8_SB(0, 0), cB, voffB); PG8_STAGE(PG8_SA(0, 0), cA, voffA); PG8_STAGE(PG8_SB(0, 1), cB + hstep, voffB); PG8_STAGE(PG8_SA(0, 1), cA + hstep, voffA);
        if (wr == 1) PG8_BAR;
        PG8_WAIT_V(4); PG8_BAR;
        PG8_STAGE(PG8_SB(1, 0), cB + kstep, voffB); PG8_STAGE(PG8_SA(1, 0), cA + kstep, voffA); PG8_STAGE(PG8_SB(1, 1), cB + hstep + kstep, voffB);
        PG8_WAIT_V(6); PG8_BAR;
    }
    for (;;) {
        const bool has_next = S.next(ui + 1, nxt);
        const char* nA = has_next ? (const char*)g.A + (size_t)nxt.pm * tstep : cA; const char* nB = has_next ? (const char*)g.Bt + (size_t)nxt.pn * tstep : cB;
#pragma nounroll
        for (int t = 0; t < nt; t += 2) {
            const bool last = (t == nt - 2);
            const char* a1 = cA + (size_t)(t + 1) * kstep;
            const char* a2 = last ? nA : cA + (size_t)(t + 2) * kstep; const char* b2 = last ? nB : cB + (size_t)(t + 2) * kstep;
            const char* a3 = a2 + kstep; const char* b3 = b2 + kstep;
            if (last && has_next) S.a_ready(nxt);
            if constexpr (SP2) {
            PG8_LDB(B0, 0, 0); PG8_LDB(B1, 0, 1); PG8_SCHED; PG8_LDA(At, 0, 0); PG8_STAGE(PG8_SA(1, 1), a1 + hstep, voffA);
            PG8_WAIT_V(8); PG8_WAIT_L(0); PG8_BAR; PG8_MMA(0, 0, At, B0); PG8_MMA(0, 1, At, B1); PG8_BAR; PG8_SCHED;
            PG8_LDA(At, 0, 1); PG8_STAGE(PG8_SB(0, 0), b2, voffB); PG8_STAGE(PG8_SB(0, 1), b2 + hstep, voffB); PG8_STAGE(PG8_SA(0, 0), a2, voffA);
            PG8_WAIT_V(8); PG8_WAIT_L(0); PG8_BAR; PG8_MMA(1, 0, At, B0); PG8_MMA(1, 1, At, B1); PG8_BAR; PG8_SCHED;
            PG8_LDB(B0, 1, 0); PG8_LDB(B1, 1, 1); PG8_SCHED; PG8_LDA(At, 1, 0); PG8_STAGE(PG8_SA(0, 1), a2 + hstep, voffA);
            PG8_WAIT_V(8); PG8_WAIT_L(0); PG8_BAR; PG8_MMA(0, 0, At, B0); PG8_MMA(0, 1, At, B1); PG8_BAR; PG8_SCHED;
            PG8_LDA(At, 1, 1); PG8_STAGE(PG8_SB(1, 0), b3, voffB); PG8_STAGE(PG8_SB(1, 1), b3 + hstep, voffB); PG8_STAGE(PG8_SA(1, 0), a3, voffA);
            PG8_WAIT_V(8); PG8_WAIT_L(0); PG8_BAR; PG8_MMA(1, 0, At, B0); PG8_MMA(1, 1, At, B1); PG8_BAR; PG8_SCHED;
            } else {
            PG8_LDB(B0, 0, 0); PG8_SCHED; PG8_LDA(At, 0, 0); PG8_STAGE(PG8_SA(1, 1), a1 + hstep, voffA);
            PG8_WAIT_L(8); PG8_BAR; PG8_WAIT_L(0); PG8_MMA(0, 0, At, B0); PG8_BAR; PG8_SCHED;
            PG8_LDB(B1, 0, 1); PG8_STAGE(PG8_SB(0, 0), b2, voffB);
            PG8_BAR; PG8_WAIT_L(0); PG8_MMA(0, 1, At, B1); PG8_BAR;
            PG8_LDA(At, 0, 1); PG8_STAGE(PG8_SA(0, 0), a2, voffA);
            PG8_BAR; PG8_WAIT_L(0); PG8_MMA(1, 0, At, B0); PG8_BAR; PG8_SCHED;
            PG8_STAGE(PG8_SB(0, 1), b2 + hstep, voffB);
            PG8_WAIT_V(6); PG8_BAR; PG8_MMA(1, 1, At, B1); PG8_BAR;
            PG8_LDB(B0, 1, 0); PG8_SCHED; PG8_LDA(At, 1, 0); PG8_STAGE(PG8_SA(0, 1), a2 + hstep, voffA);
            PG8_WAIT_L(8); PG8_BAR; PG8_WAIT_L(0); PG8_MMA(0, 0, At, B0); PG8_BAR; PG8_SCHED;
            PG8_LDB(B1, 1, 1); PG8_STAGE(PG8_SB(1, 0), b3, voffB);
            PG8_BAR; PG8_WAIT_L(0); PG8_MMA(0, 1, At, B1); PG8_BAR;
            PG8_LDA(At, 1, 1); PG8_STAGE(PG8_SA(1, 0), a3, voffA);
            PG8_BAR; PG8_WAIT_L(0); PG8_MMA(1, 0, At, B0); PG8_BAR; PG8_SCHED;
            PG8_STAGE(PG8_SB(1, 1), b3 + hstep, voffB);
            PG8_WAIT_V(6); PG8_BAR; PG8_MMA(1, 1, At, B1); PG8_BAR;
            }
        }
        if constexpr (ALIGN_EPI) { if (wr == 0) PG8_BAR; }
        if constexpr (!Epi::AFTER_DRAIN) { E(acc, cur, wr, wc, fr, fq); S.done(cur); }
        if (!has_next) break;
#pragma unroll
        for (int a = 0; a < 2; ++a)
#pragma unroll
            for (int b = 0; b < 2; ++b)
#pragma unroll
                for (int m = 0; m < 4; ++m)
#pragma unroll
                    for (int n = 0; n < 2; ++n) acc[a][b][m][n] = (f32x4){0.f, 0.f, 0.f, 0.f};
        cur = nxt; cA = nA; cB = nB; ++ui;
        if constexpr (ALIGN_EPI) { if (wr == 1) PG8_BAR; }
    }
    PG8_WAIT_V(0);
    if constexpr (!ALIGN_EPI) { if (wr == 0) PG8_BAR; }
    PG8_BAR;
    if constexpr (Epi::AFTER_DRAIN) { E.fused(acc, cur, wr, wc, fr, fq, lds, wid, lane); S.done(cur); }
#undef PG8_SA
#undef PG8_SB
#undef PG8_STAGE
#undef PG8_LDA
#undef PG8_LDB
#undef PG8_MMA
#undef PG8_WAIT_V
#undef PG8_WAIT_L
#undef PG8_BAR
#undef PG8_SCHED
}

#define EPI_V8(v, acc, ai, bj, m) const float v[8] = {acc[ai][bj][m][0][0], acc[ai][bj][m][0][1], acc[ai][bj][m][0][2], acc[ai][bj][m][0][3], acc[ai][bj][m][1][0], acc[ai][bj][m][1][1], acc[ai][bj][m][1][2], acc[ai][bj][m][1][3]}
__device__ __forceinline__ void st8(bf16_t* p, float a0, float a1, float a2, float a3, float a4, float a5, float a6, float a7) {
    u32x4 w; w.x = ::pk2(a0, a1); w.y = ::pk2(a2, a3); w.z = ::pk2(a4, a5); w.w = ::pk2(a6, a7); *(u32x4*)p = w;
}
struct Epi1 {
    static constexpr bool PERM = true, AFTER_DRAIN = false;
    unsigned char* ws;
    __device__ __forceinline__ void operator()(const f32x4 (&acc)[2][2][4][2], const Unit& u, int wr, int wc, int fr, int fq) const {
        const float* csA = (const float*)(ws + WS_CSA); const float* csB = (const float*)(ws + WS_CSB); bf16_t* Ka = (bf16_t*)(ws + WS_KA);
#pragma unroll
        for (int bj = 0; bj < 2; ++bj) {
            const int cg = u.pn * BM + bj * HALF + wc * 32;
            if (cg >= INW) continue;
            const int row0 = u.pm * BM + wr * 64 + fr;
            if (cg < 640 || (cg >= 2208 && cg < 2720)) {
                const size_t off = (cg < 384) ? WS_CQ : ((cg < 640) ? WS_CKV : WS_VB); const int ld = (cg < 384) ? 384 : ((cg < 640) ? 256 : 512), cc = (cg < 384) ? cg : ((cg < 640) ? cg - 384 : cg - 2208);
                bf16_t* dst = (bf16_t*)(ws + off);
#pragma unroll
                for (int ai = 0; ai < 2; ++ai)
#pragma unroll
                    for (int m = 0; m < 4; ++m) { EPI_V8(v, acc, ai, bj, m); st8(dst + (size_t)(row0 + ai * HALF + m * 16) * ld + cc + 8 * fq, v[0], v[1], v[2], v[3], v[4], v[5], v[6], v[7]); }
            } else if (cg == 640) {
#pragma unroll
                for (int ai = 0; ai < 2; ++ai)
#pragma unroll
                    for (int m = 0; m < 4; ++m) {
                        EPI_V8(v, acc, ai, bj, m); const int row = row0 + ai * HALF + m * 16;
                        const f32x4* cp = (const f32x4*)(csA + ((size_t)(row & (SEQ - 1)) * 16 + 8 * (fq & 1)) * 2);
                        const f32x4 c0 = cp[0], c1 = cp[1], c2 = cp[2], c3 = cp[3];
                        const float cs[16] = {c0[0], c0[1], c0[2], c0[3], c1[0], c1[1], c1[2], c1[3], c2[0], c2[1], c2[2], c2[3], c3[0], c3[1], c3[2], c3[3]};
                        float o[8];
#pragma unroll
                        for (int j = 0; j < 8; ++j) { const float pv = __shfl_xor(v[j], 32); o[j] = (fq < 2) ? (v[j] * cs[2 * j] - pv * cs[2 * j + 1]) : (pv * cs[2 * j + 1] + v[j] * cs[2 * j]); }
#pragma unroll
                        for (int hh = 0; hh < 8; ++hh) st8(Ka + (size_t)row * 768 + hh * 96 + 64 + 8 * fq, o[0], o[1], o[2], o[3], o[4], o[5], o[6], o[7]);
                    }
            } else if (cg < 1184 || cg >= 2720) {
                bf16_t* dst = (bf16_t*)(ws + ((cg < 1184) ? WS_GA : WS_GB)); const int cc = (cg < 1184) ? cg - 672 : cg - 2720;
#pragma unroll
                for (int ai = 0; ai < 2; ++ai)
#pragma unroll
                    for (int m = 0; m < 4; ++m) { EPI_V8(v, acc, ai, bj, m);
                        st8(dst + (size_t)(row0 + ai * HALF + m * 16) * 512 + cc + 8 * fq, ::silu(v[0]), ::silu(v[1]), ::silu(v[2]), ::silu(v[3]), ::silu(v[4]), ::silu(v[5]), ::silu(v[6]), ::silu(v[7])); }
            } else {
                const bool isq = cg < 1696; bf16_t* dst = (bf16_t*)(ws + (isq ? WS_QB : WS_KB)); const int cc = isq ? cg - 1184 : cg - 1696; const float sc = isq ? QB_SCALE : 1.f;
                const bool rope = (cc & 63) == 0;
#pragma unroll
                for (int ai = 0; ai < 2; ++ai)
#pragma unroll
                    for (int m = 0; m < 4; ++m) {
                        EPI_V8(v, acc, ai, bj, m); const int row = row0 + ai * HALF + m * 16;
                        float o[8];
                        if (rope) {
                            const f32x4* cp = (const f32x4*)(csB + (size_t)(row & (SEQ - 1)) * 16);
                            const f32x4 c0 = cp[0], c1 = cp[1], c2 = cp[2], c3 = cp[3];
                            const float cs[16] = {c0[0], c0[1], c0[2], c0[3], c1[0], c1[1], c1[2], c1[3], c2[0], c2[1], c2[2], c2[3], c3[0], c3[1], c3[2], c3[3]};
#pragma unroll
                            for (int j = 0; j < 8; ++j) { const float pv = __shfl_xor(v[j], 16); const float a = v[j] * cs[2 * j] - pv * cs[2 * j + 1], b = pv * cs[2 * j + 1] + v[j] * cs[2 * j]; o[j] = (fq == 0) ? a : ((fq == 1) ? b : v[j]); }
                        } else {
#pragma unroll
                            for (int j = 0; j < 8; ++j) o[j] = v[j];
                        }
                        st8(dst + (size_t)row * 512 + cc + 8 * fq, o[0] * sc, o[1] * sc, o[2] * sc, o[3] * sc, o[4] * sc, o[5] * sc, o[6] * sc, o[7] * sc);
                    }
            }
        }
    }
};
struct EpiQ {
    static constexpr bool PERM = true, AFTER_DRAIN = false;
    bf16_t* Qa; const float* csA; const float* rs;
    __device__ __forceinline__ void operator()(const f32x4 (&acc)[2][2][4][2], const Unit& u, int wr, int wc, int fr, int fq) const {
#pragma unroll
        for (int bj = 0; bj < 2; ++bj) {
            const int cg = u.pn * BM + bj * HALF + wc * 32;
            const bool rope = (cg % 96) == 64;
#pragma unroll
            for (int ai = 0; ai < 2; ++ai)
#pragma unroll
                for (int m = 0; m < 4; ++m) {
                    EPI_V8(v, acc, ai, bj, m); const int rl = ai * HALF + wr * 64 + m * 16 + fr, row = u.pm * BM + rl;
                    const float s = rs[rl];
                    float o[8];
                    if (rope) {
                        const f32x4* cp = (const f32x4*)(csA + ((size_t)(row & (SEQ - 1)) * 16 + 8 * (fq & 1)) * 2);
                        const f32x4 c0 = cp[0], c1 = cp[1], c2 = cp[2], c3 = cp[3];
                        const float cs[16] = {c0[0], c0[1], c0[2], c0[3], c1[0], c1[1], c1[2], c1[3], c2[0], c2[1], c2[2], c2[3], c3[0], c3[1], c3[2], c3[3]};
#pragma unroll
                        for (int j = 0; j < 8; ++j) { const float pv = __shfl_xor(v[j], 32); o[j] = (fq < 2) ? (v[j] * cs[2 * j] - pv * cs[2 * j + 1]) : (pv * cs[2 * j + 1] + v[j] * cs[2 * j]); }
                    } else {
#pragma unroll
                        for (int j = 0; j < 8; ++j) o[j] = v[j];
                    }
                    const float sc = s * QA_SCALE;
                    st8(Qa + (size_t)row * 768 + cg + 8 * fq, o[0] * sc, o[1] * sc, o[2] * sc, o[3] * sc, o[4] * sc, o[5] * sc, o[6] * sc, o[7] * sc);
                }
        }
    }
};
struct EpiKV {
    static constexpr bool PERM = true, AFTER_DRAIN = false;
    unsigned char* ws; const float* rs;
    __device__ __forceinline__ void operator()(const f32x4 (&acc)[2][2][4][2], const Unit& u, int wr, int wc, int fr, int fq) const {
#pragma unroll
        for (int bj = 0; bj < 2; ++bj) {
            const int cg = u.pn * BM + bj * HALF + wc * 32, hh = cg >> 7, w = cg & 127;
            const size_t off = (w < 64) ? (WS_KA + (size_t)(hh * 96 + w) * 2) : (WS_VA + (size_t)(hh * 64 + (w - 64)) * 2); const int ld = (w < 64) ? 768 : 512;
            bf16_t* dst = (bf16_t*)(ws + off);
#pragma unroll
            for (int ai = 0; ai < 2; ++ai)
#pragma unroll
                for (int m = 0; m < 4; ++m) {
                    EPI_V8(v, acc, ai, bj, m); const int rl = ai * HALF + wr * 64 + m * 16 + fr, row = u.pm * BM + rl; const float s = rs[rl];
                    st8(dst + (size_t)row * ld + 8 * fq, v[0] * s, v[1] * s, v[2] * s, v[3] * s, v[4] * s, v[5] * s, v[6] * s, v[7] * s);
                }
        }
    }
};
struct EpiOut {
    static constexpr bool PERM = true, AFTER_DRAIN = false;
    const float* x; float* out;
    __device__ __forceinline__ void operator()(const f32x4 (&acc)[2][2][4][2], const Unit& u, int wr, int wc, int fr, int fq) const {
#pragma unroll
        for (int bj = 0; bj < 2; ++bj) {
            const int cg = u.pn * BM + bj * HALF + wc * 32;
#pragma unroll
            for (int ai = 0; ai < 2; ++ai)
#pragma unroll
                for (int m = 0; m < 4; ++m) {
                    const size_t o = (size_t)(u.pm * BM + ai * HALF + wr * 64 + m * 16 + fr) * DM + cg + 8 * fq;
                    const f32x4 x0 = *(const f32x4*)(x + o), x1 = *(const f32x4*)(x + o + 4);
                    *(f32x4*)(out + o) = x0 * DN_ALPHA + acc[ai][bj][m][0]; *(f32x4*)(out + o + 4) = x1 * DN_ALPHA + acc[ai][bj][m][1];
                }
        }
    }
};
}

DI void row_rms(const bf16_t* A, int K, int row0, float* rs) {
    const int tid = tid_l(), row = tid >> 1, half = tid & 1;
    const int nch = K >> 4;
    const u32x4* p = (const u32x4*)(A + (size_t)(row0 + row) * K + half * (K >> 1));
    float s = 0.f;
    for (int c = 0; c < nch; ++c) {
        const u32x4 v = p[c];
#pragma unroll
        for (int j = 0; j < 4; ++j) { const float a = bf_lo(v[j]), b = bf_hi(v[j]); s += a * a + b * b; }
    }
    s += __shfl_xor(s, 1);
    if (half == 0) rs[row] = __builtin_amdgcn_rsqf(s / (float)K + 1e-6f);
    __syncthreads();
}

DI void mla_item(const Params& p, int b, int hh, int qb, char* lds) {
    const bf16_t* Qa = (const bf16_t*)(p.ws + WS_QA); const bf16_t* Ka = (const bf16_t*)(p.ws + WS_KA); const bf16_t* Va = (const bf16_t*)(p.ws + WS_VA);
    const bf16_t* gA = (const bf16_t*)(p.ws + WS_GA); bf16_t* mix = (bf16_t*)(p.ws + WS_MIX);
    const int tid = tid_l(), lane = tid & 63, wid = tid >> 6, r = lane & 31, h = lane >> 5;
    const size_t tokbase = (size_t)b * SEQ;
    const int q0 = qb * 256, qpos = q0 + wid * 32 + r;
    bf16x8 qf[6];
    { const bf16_t* qrow = Qa + (tokbase + qpos) * 768 + hh * 96 + 8 * h;
#pragma unroll
      for (int s = 0; s < 6; ++s) qf[s] = *(const bf16x8*)(qrow + 16 * s); }
    int kg[2], kl[2];
#pragma unroll
    for (int i = 0; i < 2; ++i) { const int c = tid + 512 * i, key = c / 12, cc = c - key * 12; kg[i] = key * 768 + cc * 8; kl[i] = (cc < 8) ? sw128(key, cc) : (8192 + sw64(key, cc - 8)); }
    const bool k2 = tid < 256;
    const int vkey = tid >> 3, vcc = tid & 7, vg = vkey * 512 + vcc * 8, vl = 12288 + swV(vkey, vcc);
    const bf16_t* kbase = Ka + tokbase * 768 + hh * 96;
    const bf16_t* vbase = Va + tokbase * 512 + hh * 64;
    const int tp = lane & 3, tq = (lane >> 2) & 3, tblk = (lane >> 4) & 1;
    const int vswz = ((tq >> 1) & 1) << 2;

    f32x16 o[2]; o[0] = zero16(); o[1] = zero16();
    float m = NEGBIG, l = 0.f;
    const int ntiles = 4 * qb + 4;
    u32x4 rk0, rk1 = (u32x4){0u, 0u, 0u, 0u}, rv;
    rk0 = *(const u32x4*)(kbase + kg[0]); if (k2) rk1 = *(const u32x4*)(kbase + kg[1]); rv = *(const u32x4*)(vbase + vg);
    for (int t = 0; t < ntiles; ++t) {
        char* st = lds + (t & 1) * 20480;
        *(u32x4*)(st + kl[0]) = rk0; if (k2) *(u32x4*)(st + kl[1]) = rk1; *(u32x4*)(st + vl) = rv;
        __syncthreads();
        if (t + 1 < ntiles) {
            const size_t ko = (size_t)(t + 1) * 64 * 768, vo = (size_t)(t + 1) * 64 * 512;
            rk0 = *(const u32x4*)(kbase + ko + kg[0]); if (k2) rk1 = *(const u32x4*)(kbase + ko + kg[1]); rv = *(const u32x4*)(vbase + vo + vg);
        }
        const int k0 = t * 64;
        if (k0 <= q0 + wid * 32 + 31) {
            f32x16 s[2];
#pragma unroll
            for (int kt = 0; kt < 2; ++kt) {
                s[kt] = zero16();
                const int kr = kt * 32 + r;
#pragma unroll
                for (int ss = 0; ss < 6; ++ss) {
                    const bf16x8 kf = (ss < 4) ? lds_r128(st + sw128(kr, 2 * ss + h)) : lds_r128(st + 8192 + sw64(kr, 2 * (ss - 4) + h));
                    s[kt] = MFMA(kf, qf[ss], s[kt]);
                }
            }
            if (k0 + 63 > q0 + wid * 32) {
#pragma unroll
                for (int kt = 0; kt < 2; ++kt)
#pragma unroll
                    for (int i = 0; i < 16; ++i) { const int key = k0 + kt * 32 + crow(i, h); if (key > qpos) s[kt][i] = NEGBIG; }
            }
            float mx = s[0][0];
#pragma unroll
            for (int kt = 0; kt < 2; ++kt)
#pragma unroll
                for (int i = 0; i < 16; ++i) mx = fmaxf(mx, s[kt][i]);
            mx = fmaxf(mx, __shfl_xor(mx, 32));
            const float mnew = fmaxf(m, mx);
            const float alpha = __builtin_amdgcn_exp2f(m - mnew);
            float ps = 0.f;
#pragma unroll
            for (int kt = 0; kt < 2; ++kt)
#pragma unroll
                for (int i = 0; i < 16; ++i) { const float e = __builtin_amdgcn_exp2f(s[kt][i] - mnew); s[kt][i] = e; ps += e; }
            ps += __shfl_xor(ps, 32);
            l = l * alpha + ps; m = mnew;
#pragma unroll
            for (int dt = 0; dt < 2; ++dt)
#pragma unroll
                for (int i = 0; i < 16; ++i) o[dt][i] *= alpha;
#pragma unroll
            for (int kt = 0; kt < 2; ++kt)
#pragma unroll
                for (int ss = 0; ss < 2; ++ss) {
                    const bf16x8 pb = pack8(s[kt], ss);
                    const int key_lo = kt * 32 + 16 * ss + 4 * h + tq;
#pragma unroll
                    for (int dt = 0; dt < 2; ++dt) {
                        const int ch = (dt * 4 + 2 * tblk + (tp >> 1)) ^ vswz;
                        const char* a0 = st + 12288 + key_lo * 128 + (ch << 4) + 8 * (tp & 1);
                        const s16x4 lo = lds_tr(a0), hi = lds_tr(a0 + 8 * 128);
                        const bf16x8 vf = __builtin_shufflevector(lo, hi, 0, 1, 2, 3, 4, 5, 6, 7);
                        o[dt] = MFMA(vf, pb, o[dt]);
                    }
                }
        }
    }
    const float inv = 1.f / l;
    const size_t tok = tokbase + qpos;
#pragma unroll
    for (int dt = 0; dt < 2; ++dt)
#pragma unroll
        for (int g = 0; g < 4; ++g) {
            const int dv = dt * 32 + 8 * g + 4 * h;
            const u32x2 gv = *(const u32x2*)(gA + tok * 512 + hh * 64 + dv);
            u32x2 w;
            w[0] = pk2(o[dt][4 * g + 0] * inv * bf_lo(gv[0]), o[dt][4 * g + 1] * inv * bf_hi(gv[0]));
            w[1] = pk2(o[dt][4 * g + 2] * inv * bf_lo(gv[1]), o[dt][4 * g + 3] * inv * bf_hi(gv[1]));
            *(u32x2*)(mix + tok * 1024 + hh * 64 + dv) = w;
        }
    __syncthreads();
}

DI void dil_item(const Params& p, int br, int b, int hh, int res, int nb2, char* lds) {
    const bf16_t* Qb = (const bf16_t*)(p.ws + WS_QB); const bf16_t* Kb = (const bf16_t*)(p.ws + WS_KB); const bf16_t* Vb = (const bf16_t*)(p.ws + WS_VB);
    bf16_t* opart = (bf16_t*)(p.ws + WS_OPART); float* lse = (float*)(p.ws + WS_LSE);
    const int tid = tid_l(), lane = tid & 63, wid = tid >> 6, r = lane & 31, h = lane >> 5;
    const int d = (br == 0) ? 1 : ((br == 1) ? 4 : 16);
    const size_t tokbase = (size_t)b * SEQ;
    {
        const int cc = tid & 7, kkb = tid >> 3;
        u32x4 rk[6], rv[6];
#pragma unroll
        for (int i = 0; i < 6; ++i) {
            const int kk = kkb + 64 * i, km = 256 * nb2 - 128 + kk;
            if (km >= 0) {
                const size_t off = (tokbase + (size_t)km * d + res) * 512 + hh * 64 + cc * 8;
                rk[i] = *(const u32x4*)(Kb + off); rv[i] = *(const u32x4*)(Vb + off);
            } else { rk[i] = (u32x4){0u, 0u, 0u, 0u}; rv[i] = (u32x4){0u, 0u, 0u, 0u}; }
        }
#pragma unroll
        for (int i = 0; i < 6; ++i) { const int kk = kkb + 64 * i; *(u32x4*)(lds + sw128(kk, cc)) = rk[i]; *(u32x4*)(lds + 49152 + swV(kk, cc)) = rv[i]; }
    }
    const int qm = 256 * nb2 + wid * 32 + r;
    const size_t qtok = tokbase + (size_t)qm * d + res;
    bf16x8 qf[4];
    { const bf16_t* qrow = Qb + qtok * 512 + hh * 64 + 8 * h;
#pragma unroll
      for (int s = 0; s < 4; ++s) qf[s] = *(const bf16x8*)(qrow + 16 * s); }
    __syncthreads();
    f32x16 s[5];
#pragma unroll
    for (int u = 0; u < 5; ++u) {
        const bool skip = (nb2 == 0) && (wid + u < 4);
        if (!skip) {
            s[u] = zero16();
            const int kr = 32 * (wid + u) + r;
#pragma unroll
            for (int ss = 0; ss < 4; ++ss) s[u] = MFMA(lds_r128(lds + sw128(kr, 2 * ss + h)), qf[ss], s[u]);
        } else {
#pragma unroll
            for (int i = 0; i < 16; ++i) s[u][i] = NEGBIG;
        }
    }
#pragma unroll
    for (int i = 0; i < 16; ++i) { const int j = crow(i, h); if (j < r) s[0][i] = NEGBIG; if (j > r) s[4][i] = NEGBIG; }
    float mx = s[0][0];
#pragma unroll
    for (int u = 0; u < 5; ++u)
#pragma unroll
        for (int i = 0; i < 16; ++i) mx = fmaxf(mx, s[u][i]);
    mx = fmaxf(mx, __shfl_xor(mx, 32));
    float l = 0.f;
#pragma unroll
    for (int u = 0; u < 5; ++u)
#pragma unroll
        for (int i = 0; i < 16; ++i) { const float e = __builtin_amdgcn_exp2f(s[u][i] - mx); s[u][i] = e; l += e; }
    l += __shfl_xor(l, 32);
    f32x16 o[2]; o[0] = zero16(); o[1] = zero16();
    const int tp = lane & 3, tq = (lane >> 2) & 3, tblk = (lane >> 4) & 1;
    const int vswz = ((tq >> 1) & 1) << 2;
#pragma unroll
    for (int u = 0; u < 5; ++u) {
        const bool skip = (nb2 == 0) && (wid + u < 4);
        if (!skip) {
#pragma unroll
            for (int ss = 0; ss < 2; ++ss) {
                const bf16x8 pb = pack8(s[u], ss);
                const int key_lo = 32 * (wid + u) + 16 * ss + 4 * h + tq;
#pragma unroll
                for (int dt = 0; dt < 2; ++dt) {
                    const int ch = (dt * 4 + 2 * tblk + (tp >> 1)) ^ vswz;
                    const char* a0 = lds + 49152 + key_lo * 128 + (ch << 4) + 8 * (tp & 1);
                    const s16x4 lo = lds_tr(a0), hi = lds_tr(a0 + 8 * 128);
                    const bf16x8 vf = __builtin_shufflevector(lo, hi, 0, 1, 2, 3, 4, 5, 6, 7);
                    o[dt] = MFMA(vf, pb, o[dt]);
                }
            }
        }
    }
    const float inv = 1.f / l;
    bf16_t* op = opart + ((size_t)br * T + qtok) * 512 + hh * 64;
#pragma unroll
    for (int dt = 0; dt < 2; ++dt)
#pragma unroll
        for (int g = 0; g < 4; ++g) {
            const int dv = dt * 32 + 8 * g + 4 * h;
            u32x2 w;
            w[0] = pk2(o[dt][4 * g + 0] * inv, o[dt][4 * g + 1] * inv);
            w[1] = pk2(o[dt][4 * g + 2] * inv, o[dt][4 * g + 3] * inv);
            *(u32x2*)(op + dv) = w;
        }
    if (h == 0) lse[((size_t)br * T + qtok) * 8 + hh] = mx + __builtin_amdgcn_logf(l);
    __syncthreads();
}
#define XB_TMO      128
#define XB_XCNT(j)  (256  + 64 * (j))
#define XB_XSUB(j)  (1280 + 64 * (j))
#define XB_XGEN(j)  (2304 + 64 * (j))
#define XB_TOP      3328
#define XB_TOPGEN   3392
#define XCD_BAR_WORDS 3456
#define XB_SPIN_CAP (1u << 18)
DI unsigned xb_ld(unsigned* p)              { return __hip_atomic_load(p, __ATOMIC_RELAXED, __HIP_MEMORY_SCOPE_AGENT); }
DI unsigned xb_add(unsigned* p, unsigned v) { return __hip_atomic_fetch_add(p, v, __ATOMIC_RELAXED, __HIP_MEMORY_SCOPE_AGENT); }
DI unsigned xb_xcc_id() { return (unsigned)__builtin_amdgcn_s_getreg((3 << 11) | 20) & 0xFu; }
#define XB_SPIN(cond, bar) do { unsigned _sp = 0; while (cond) { __builtin_amdgcn_s_sleep(1); \
    if ((++_sp & 255u) == 0u) { if (xb_ld(&(bar)[XB_TMO])) break; if (_sp > XB_SPIN_CAP) { atomicAdd(&(bar)[XB_TMO], 1u); break; } } } } while (0)
struct XcdBarrier { unsigned* bar; unsigned x; volatile LAS unsigned* st; };
DI XcdBarrier xcd_barrier_post(unsigned* bar, volatile LAS unsigned* st) {
    XcdBarrier b; b.bar = bar; b.x = xb_xcc_id(); b.st = st;
    if (threadIdx.x == 0) (void)xb_add(&bar[XB_XCNT(b.x)], 1u);
    return b;
}
DI void xcd_barrier_complete(unsigned* bar, unsigned x, unsigned& nloc, unsigned& nx) {
    const unsigned G = gridDim.x * gridDim.y * gridDim.z;
    unsigned sum, cnt, mine, sp = 0u;
    for (;;) {
        sum = 0u; cnt = 0u; mine = 0u;
#pragma unroll
        for (unsigned j = 0; j < 16; ++j) { const unsigned c = xb_ld(&bar[XB_XCNT(j)]); sum += c; cnt += (c > 0u) ? 1u : 0u; mine = (j == x) ? c : mine; }
        if (sum == G) break;
        __builtin_amdgcn_s_sleep(1);
        if ((++sp & 255u) == 0u) { if (xb_ld(&bar[XB_TMO])) break; if (sp > XB_SPIN_CAP) { atomicAdd(&bar[XB_TMO], 1u); break; } }
    }
    nloc = mine > 0u ? mine : 1u; nx = cnt > 0u ? cnt : 1u;
}
DI void xcd_barrier(const XcdBarrier& b) {
    asm volatile("s_waitcnt vmcnt(0)" ::: "memory");
    __syncthreads();
    if (threadIdx.x == 0) {
        unsigned* bar = b.bar;
        __builtin_amdgcn_s_waitcnt(0);
        unsigned nloc = b.st[0], nx = b.st[1];
        if (nloc == 0u) { xcd_barrier_complete(bar, b.x, nloc, nx); b.st[0] = nloc; b.st[1] = nx; }
        const unsigned old = xb_add(&bar[XB_XSUB(b.x)], 1u);
        const unsigned gen = old / nloc;
        if (old + 1u == (gen + 1u) * nloc) {
            __builtin_amdgcn_fence(__ATOMIC_RELEASE, "agent");
            asm volatile("s_waitcnt vmcnt(0)" ::: "memory");
            const unsigned og = xb_add(&bar[XB_TOP], 1u);
            const unsigned tg = og / nx;
            if (og + 1u == (tg + 1u) * nx) xb_add(&bar[XB_TOPGEN], 1u);
            else XB_SPIN(xb_ld(&bar[XB_TOPGEN]) == tg, bar);
            __builtin_amdgcn_fence(__ATOMIC_ACQUIRE, "agent");
            xb_add(&bar[XB_XGEN(b.x)], 1u);
            asm volatile("s_waitcnt vmcnt(0)" ::: "memory");
        } else {
            XB_SPIN(xb_ld(&bar[XB_XGEN(b.x)]) == gen, bar);
            __builtin_amdgcn_fence(__ATOMIC_ACQUIRE, "agent");
            asm volatile("s_waitcnt vmcnt(0)" ::: "memory");
        }
    }
    __syncthreads();
}

DI void phase0(const Params& p) {
    const size_t gtid = (size_t)blockIdx.x * NTHREADS + threadIdx.x, gsz = (size_t)gridDim.x * NTHREADS;
    { u32x4* xb = (u32x4*)(p.ws + WS_XB); const f32x4* x4 = (const f32x4*)p.x;
      for (size_t i = gtid; i < (size_t)T * 1024 / 8; i += gsz) { const f32x4 a = x4[2 * i], b = x4[2 * i + 1]; u32x4 w; w[0] = pk2(a[0], a[1]); w[1] = pk2(a[2], a[3]); w[2] = pk2(b[0], b[1]); w[3] = pk2(b[2], b[3]); xb[i] = w; } }
    { bf16_t* wt = (bf16_t*)(p.ws + WS_WINT);
      for (size_t i = gtid; i < (size_t)INWP * 128; i += gsz) { const int n = (int)(i % INWP), k8 = (int)(i / INWP); float v[8];
#pragma unroll
        for (int j = 0; j < 8; ++j) v[j] = (n < INW) ? p.w_in[(size_t)(k8 * 8 + j) * INW + n] : 0.f;
        u32x4 w; w[0] = pk2(v[0], v[1]); w[1] = pk2(v[2], v[3]); w[2] = pk2(v[4], v[5]); w[3] = pk2(v[6], v[7]); *(u32x4*)(wt + (size_t)n * 1024 + k8 * 8) = w; } }
    { bf16_t* wt = (bf16_t*)(p.ws + WS_WUQT);
      for (size_t i = gtid; i < (size_t)768 * 48; i += gsz) { const int n = (int)(i % 768), k8 = (int)(i / 768); float v[8];
#pragma unroll
        for (int j = 0; j < 8; ++j) v[j] = p.w_uq[(size_t)(k8 * 8 + j) * 768 + n] * p.qg[k8 * 8 + j];
        u32x4 w; w[0] = pk2(v[0], v[1]); w[1] = pk2(v[2], v[3]); w[2] = pk2(v[4], v[5]); w[3] = pk2(v[6], v[7]); *(u32x4*)(wt + (size_t)n * 384 + k8 * 8) = w; } }
    { bf16_t* wt = (bf16_t*)(p.ws + WS_WUKVT);
      for (size_t i = gtid; i < (size_t)1024 * 32; i += gsz) { const int n = (int)(i % 1024), k8 = (int)(i / 1024); float v[8];
#pragma unroll
        for (int j = 0; j < 8; ++j) v[j] = p.w_ukv[(size_t)(k8 * 8 + j) * 1024 + n] * p.kvg[k8 * 8 + j];
        u32x4 w; w[0] = pk2(v[0], v[1]); w[1] = pk2(v[2], v[3]); w[2] = pk2(v[4], v[5]); w[3] = pk2(v[6], v[7]); *(u32x4*)(wt + (size_t)n * 256 + k8 * 8) = w; } }
    { bf16_t* wt = (bf16_t*)(p.ws + WS_WOUTT);
      for (size_t i = gtid; i < (size_t)1024 * 128; i += gsz) { const int n = (int)(i % 1024), k8 = (int)(i / 1024); float v[8];
#pragma unroll
        for (int j = 0; j < 8; ++j) v[j] = p.w_out[(size_t)(k8 * 8 + j) * 1024 + n];
        u32x4 w; w[0] = pk2(v[0], v[1]); w[1] = pk2(v[2], v[3]); w[2] = pk2(v[4], v[5]); w[3] = pk2(v[6], v[7]); *(u32x4*)(wt + (size_t)n * 1024 + k8 * 8) = w; } }
    { f32x2* csA = (f32x2*)(p.ws + WS_CSA); f32x2* csB = (f32x2*)(p.ws + WS_CSB);
      for (size_t i = gtid; i < (size_t)SEQ * 24; i += gsz) {
          int pos, f, dim; f32x2* dst;
          if (i < (size_t)SEQ * 16) { pos = (int)(i >> 4); f = (int)(i & 15); dim = 32; dst = csA + i; } else { const size_t j = i - (size_t)SEQ * 16; pos = (int)(j >> 3); f = (int)(j & 7); dim = 16; dst = csB + j; }
          const float invf = __builtin_exp2f(-(float)(2 * f) / (float)dim * 18.931568569324174f);
          const float ang = (float)pos * invf;
          const double rev = (double)ang * 0.15915494309189535;
          const float fr = (float)(rev - __builtin_rint(rev));
          *dst = (f32x2){__builtin_amdgcn_cosf(fr), __builtin_amdgcn_sinf(fr)};
      } }
}

DI void phase1(const Params& p, LAS unsigned char* ldsL) {
    pg8::Epi1 e; e.ws = p.ws;
    pg8::Gemm g{(const bf16_t*)(p.ws + WS_XB), (const bf16_t*)(p.ws + WS_WINT), T, INWP, 1024};
    pg8::StaticOrder S; S.init(T, INWP, (int)gridDim.x, (int)blockIdx.x);
    pg8::gemm_phase<pg8::Epi1, pg8::StaticOrder, true, true>(ldsL, g, S, e);
}

DI void phase2(const Params& p, char* lds, LAS unsigned char* ldsL) {
    float* rs = (float*)(lds + LDS_TAIL);
    {
        const bf16_t* cq = (const bf16_t*)(p.ws + WS_CQ);
        pg8::StaticOrder S; S.init(T, 768, (int)gridDim.x, (int)blockIdx.x);
        pg8::Unit u;
        if (S.next(0, u)) {
            row_rms(cq, 384, u.pm * 256, rs);
            pg8::Gemm g{cq, (const bf16_t*)(p.ws + WS_WUQT), T, 768, 384};
            pg8::EpiQ e; e.Qa = (bf16_t*)(p.ws + WS_QA); e.csA = (const float*)(p.ws + WS_CSA); e.rs = rs;
            pg8::gemm_phase<pg8::EpiQ, pg8::StaticOrder, true, true>(ldsL, g, S, e);
        }
    }
    __syncthreads();
    {
        const bf16_t* ckv = (const bf16_t*)(p.ws + WS_CKV);
        pg8::StaticOrder S; S.init(T, 1024, (int)gridDim.x, (int)blockIdx.x);
        pg8::Unit u;
        if (S.next(0, u)) {
            row_rms(ckv, 256, u.pm * 256, rs);
            pg8::Gemm g{ckv, (const bf16_t*)(p.ws + WS_WUKVT), T, 1024, 256};
            pg8::EpiKV e; e.ws = p.ws; e.rs = rs;
            pg8::gemm_phase<pg8::EpiKV, pg8::StaticOrder, true, true>(ldsL, g, S, e);
        }
    }
    __syncthreads();
}

DI void phase3(const Params& p, char* lds, int which = 0) {
    unsigned* ctr = (unsigned*)(p.ws + WS_CTR) + which;
    int* slot = (int*)(lds + LDS_TAIL + 1024);
    for (;;) {
        __syncthreads();
        if (threadIdx.x == 0) *slot = (int)atomicAdd(ctr, 1u);
        __syncthreads();
        const int it = *slot;
        if (it >= 2048) break;
        if (it < 512) {
            const int qb = 15 - (it >> 5), bh = it & 31;
            mla_item(p, bh >> 3, bh & 7, qb, lds);
        } else {
            const int j = it - 512, br = j >> 9, rem = j & 511, bh = rem >> 4, w = rem & 15;
            const int npair = (br == 0) ? 16 : ((br == 1) ? 4 : 1);
            const int res = w / npair, nb2 = w - res * npair;
            dil_item(p, br, bh >> 3, bh & 7, res, nb2, lds);
        }
    }
}

DI void phase5(const Params& p, LAS unsigned char* ldsL) {
    pg8::EpiOut e; e.x = p.x; e.out = p.out;
    pg8::Gemm g{(const bf16_t*)(p.ws + WS_MIX), (const bf16_t*)(p.ws + WS_WOUTT), T, 1024, 1024};
    pg8::StaticOrder S; S.init(T, 1024, (int)gridDim.x, (int)blockIdx.x);
    pg8::gemm_phase<pg8::EpiOut, pg8::StaticOrder, true, true>(ldsL, g, S, e);
}

DI void phase4(const Params& p) {
    const bf16_t* opart = (const bf16_t*)(p.ws + WS_OPART); const float* lse = (const float*)(p.ws + WS_LSE); const bf16_t* gB = (const bf16_t*)(p.ws + WS_GB);
    bf16_t* mix = (bf16_t*)(p.ws + WS_MIX);
    const size_t gtid = (size_t)blockIdx.x * NTHREADS + threadIdx.x, gsz = (size_t)gridDim.x * NTHREADS;
    for (size_t i = gtid; i < (size_t)T * 64; i += gsz) {
        const size_t tok = i >> 6; const int c8 = (int)(i & 63), hh = c8 >> 3;
        const float l0 = lse[tok * 8 + hh], l1 = lse[((size_t)T + tok) * 8 + hh], l2 = lse[((size_t)2 * T + tok) * 8 + hh];
        const float M = fmaxf(l0, fmaxf(l1, l2));
        float w0 = __builtin_amdgcn_exp2f(l0 - M), w1 = __builtin_amdgcn_exp2f(l1 - M), w2 = __builtin_amdgcn_exp2f(l2 - M);
        const float inv = 1.f / (w0 + w1 + w2); w0 *= inv; w1 *= inv; w2 *= inv;
        const u32x4 a = *(const u32x4*)(opart + tok * 512 + c8 * 8), b = *(const u32x4*)(opart + ((size_t)T + tok) * 512 + c8 * 8), c = *(const u32x4*)(opart + ((size_t)2 * T + tok) * 512 + c8 * 8);
        const u32x4 g = *(const u32x4*)(gB + tok * 512 + c8 * 8);
        u32x4 o;
#pragma unroll
        for (int j = 0; j < 4; ++j) {
            const float lo = (w0 * bf_lo(a[j]) + w1 * bf_lo(b[j]) + w2 * bf_lo(c[j])) * bf_lo(g[j]);
            const float hi = (w0 * bf_hi(a[j]) + w1 * bf_hi(b[j]) + w2 * bf_hi(c[j])) * bf_hi(g[j]);
            o[j] = pk2(lo, hi);
        }
        *(u32x4*)(mix + tok * 1024 + 512 + c8 * 8) = o;
    }
}

DI void phase6(const Params& p) {
    const int lane = threadIdx.x & 63, wid = threadIdx.x >> 6;
    const int gw = blockIdx.x * 8 + wid, nw = gridDim.x * 8;
    f32x4 g[4], bb[4];
#pragma unroll
    for (int j = 0; j < 4; ++j) { g[j] = *(const f32x4*)(p.ln_g + lane * 4 + 256 * j); bb[j] = *(const f32x4*)(p.ln_b + lane * 4 + 256 * j); }
    for (int row = gw; row < T; row += nw) {
        float* rp = p.out + (size_t)row * DM + lane * 4;
        f32x4 v[4]; float s = 0.f;
#pragma unroll
        for (int j = 0; j < 4; ++j) { v[j] = *(const f32x4*)(rp + 256 * j); s += (v[j][0] + v[j][1]) + (v[j][2] + v[j][3]); }
#pragma unroll
        for (int o = 32; o > 0; o >>= 1) s += __shfl_xor(s, o);
        const float mu = s * (1.f / 1024.f); float q = 0.f;
#pragma unroll
        for (int j = 0; j < 4; ++j) { v[j] = v[j] - mu; q += (v[j][0] * v[j][0] + v[j][1] * v[j][1]) + (v[j][2] * v[j][2] + v[j][3] * v[j][3]); }
#pragma unroll
        for (int o = 32; o > 0; o >>= 1) q += __shfl_xor(q, o);
        const float rstd = __builtin_amdgcn_rsqf(q * (1.f / 1024.f) + 1e-5f);
#pragma unroll
        for (int j = 0; j < 4; ++j) *(f32x4*)(rp + 256 * j) = v[j] * rstd * g[j] + bb[j];
    }
}

template <int LO, int HI>
__global__ void __launch_bounds__(NTHREADS, 2) fwd_megakernel(Params p) {
    extern __shared__ __attribute__((aligned(16))) char lds[];
    LAS unsigned char* ldsL = (LAS unsigned char*)lds;
    volatile LAS unsigned* xst = (volatile LAS unsigned*)(ldsL + LDS_TAIL + 1040);
    XcdBarrier gb; gb.bar = (unsigned*)(p.ws + WS_BAR); gb.x = 0; gb.st = xst;
    if constexpr (HI - LO > 1) {
        if (threadIdx.x == 0) { xst[0] = 0u; xst[1] = 0u; xst[2] = 0u; xst[3] = 0u; }
        __syncthreads();
        gb = xcd_barrier_post((unsigned*)(p.ws + WS_BAR), xst);
    }
#define GSYNC() xcd_barrier(gb)
    if constexpr (LO <= 0 && 0 < HI) { phase0(p); if constexpr (1 < HI) GSYNC(); }
    if constexpr (LO <= 1 && 1 < HI) { phase1(p, ldsL); if (PROBE_DUP == 1) { GSYNC(); phase1(p, ldsL); } if constexpr (2 < HI) GSYNC(); }
    if constexpr (LO <= 2 && 2 < HI) { phase2(p, lds, ldsL); if (PROBE_DUP == 2) { GSYNC(); phase2(p, lds, ldsL); } if constexpr (3 < HI) GSYNC(); }
    if constexpr (LO <= 3 && 3 < HI) { phase3(p, lds); if (PROBE_DUP == 3) { GSYNC(); phase3(p, lds, 1); } if constexpr (4 < HI) GSYNC(); }
    if constexpr (LO <= 4 && 4 < HI) { phase4(p); if constexpr (5 < HI) GSYNC(); }
    if constexpr (LO <= 5 && 5 < HI) { phase5(p, ldsL); if (PROBE_DUP == 5) { GSYNC(); phase5(p, ldsL); } if constexpr (6 < HI) GSYNC(); }
    if (PROBE_DUP == 7) { for (int i = 0; i < 10; ++i) GSYNC(); }
    if constexpr (LO <= 6 && 6 < HI) { phase6(p); }
}

extern "C" void kernel_launch(void* const* d_in, const int* in_sizes, int n_in, void* d_out, int out_size, void* d_ws, size_t ws_size, hipStream_t stream) {
    static int grid_blocks = 0;
    if (grid_blocks == 0) {
        if (n_in != 9 || ws_size < WS_END) { fprintf(stderr, "kernel_launch: unexpected n_in %d / ws %zu (need %zu)\n", n_in, ws_size, (size_t)WS_END); grid_blocks = -1; return; }
        int dev = 0, cus = 0, per_cu = 0;
        (void)hipGetDevice(&dev);
        (void)hipDeviceGetAttribute(&cus, hipDeviceAttributeMultiprocessorCount, dev);
        if (hipFuncSetAttribute((const void*)fwd_megakernel<0, 7>, hipFuncAttributeMaxDynamicSharedMemorySize, LDS_BYTES) != hipSuccess) { fprintf(stderr, "kernel_launch: hipFuncSetAttribute failed\n"); grid_blocks = -1; return; }
        if (hipOccupancyMaxActiveBlocksPerMultiprocessor(&per_cu, (const void*)fwd_megakernel<0, 7>, NTHREADS, LDS_BYTES) != hipSuccess || per_cu < 1) { fprintf(stderr, "kernel_launch: occupancy query failed (%d)\n", per_cu); grid_blocks = -1; return; }
        grid_blocks = cus;
        grid_blocks -= grid_blocks % 8;
        fprintf(stderr, "kernel_launch: cus %d per_cu %d grid %d\n", cus, per_cu, grid_blocks);
    }
    if (grid_blocks <= 0) return;
    (void)hipMemsetAsync((char*)d_ws + WS_BAR, 0, CTL_BYTES, stream);
    Params p{};
    p.x = (const float*)d_in[0]; p.w_in = (const float*)d_in[1]; p.qg = (const float*)d_in[2]; p.kvg = (const float*)d_in[3]; p.w_uq = (const float*)d_in[4];
    p.w_ukv = (const float*)d_in[5]; p.w_out = (const float*)d_in[6]; p.ln_g = (const float*)d_in[7]; p.ln_b = (const float*)d_in[8];
    p.out = (float*)d_out; p.ws = (unsigned char*)d_ws;
    hipLaunchKernelGGL((fwd_megakernel<0, 7>), dim3(grid_blocks), dim3(NTHREADS), LDS_BYTES, stream, p);
}
```
